# Optimizing an MI355X kernel written in HIP

```python
import jax, jax.numpy as jnp
from jax import lax
import numpy as np

D_MODEL = 1024
BATCH = 2
SEQ = 8192
DEPTH = 4

GRID_W = 64
CTX_LEN = 256
N_MIXERS = 3
EPS = 1e-6
POOL_WINDOWS = (2, 4, 8, 16)
POOL_GROUPS = 4
POOL_GW = D_MODEL // POOL_GROUPS
HEAD_DIM = 128
N_HEADS = D_MODEL // HEAD_DIM
N_KV_HEADS = N_HEADS // 2
QKV_WIDTH = (N_HEADS + 2 * N_KV_HEADS) * HEAD_DIM
ROPE_BASE = 10000.0
Q_BLOCK = 128
CHUNK = 128
GMLP_HALF = 2 * D_MODEL
GMLP_GROUPS = 8
GMLP_GW = GMLP_HALF // GMLP_GROUPS
D_FF = 4 * D_MODEL

kernel_name = "hybrid_pool_gqa_gmlp_dit_block"


def n_layers_of(kind):
    return len(range(kind, DEPTH, N_MIXERS))


def rms_norm(x, g):
    xf = x.astype(jnp.float32)
    y = xf * lax.rsqrt(jnp.mean(xf * xf, axis=-1, keepdims=True) + EPS)
    return (y * g.astype(jnp.float32)).astype(x.dtype)


def layer_norm(x, g, b):
    xf = x.astype(jnp.float32)
    mu = jnp.mean(xf, axis=-1, keepdims=True)
    xc = xf - mu
    y = xc * lax.rsqrt(jnp.mean(xc * xc, axis=-1, keepdims=True) + EPS)
    return (y * g.astype(jnp.float32) + b.astype(jnp.float32)).astype(x.dtype)


def modulate(h, shift, scale):
    return h * (1 + scale[:, None, :]) + shift[:, None, :]


def pool_mix(h, w, scale):
    B, L, D = h.shape
    hf = h.astype(jnp.float32)
    cs = jnp.concatenate([jnp.zeros((B, 1, D), jnp.float32), jnp.cumsum(hf, axis=1)], axis=1)
    csg = cs.reshape(B, L + 1, POOL_GROUPS, POOL_GW)
    hg = hf.reshape(B, L, POOL_GROUPS, POOL_GW)
    pos = jnp.arange(L)
    outs = []
    for g, win in enumerate(POOL_WINDOWS):
        lo = jnp.clip(pos - win // 2, 0, L)
        hi = jnp.clip(pos + win - win // 2, 0, L)
        s = jnp.take(csg[:, :, g], hi, axis=1) - jnp.take(csg[:, :, g], lo, axis=1)
        cnt = (hi - lo).astype(jnp.float32)[None, :, None]
        outs.append(s / cnt - hg[:, :, g])
    p = jnp.stack(outs, axis=2).astype(h.dtype)
    y = jnp.einsum("blgc,gcd->blgd", p, w).reshape(B, L, D)
    return y * scale


def axial_rope_tables(L):
    rows_n = L // GRID_W
    row = jnp.repeat(jnp.arange(rows_n), GRID_W).astype(jnp.float32)
    col = jnp.tile(jnp.arange(GRID_W), rows_n).astype(jnp.float32)
    half = HEAD_DIM // 2
    inv = ROPE_BASE ** (-jnp.arange(0, half, 2, dtype=jnp.float32) / half)
    ang_r = row[:, None] * inv[None, :]
    ang_c = col[:, None] * inv[None, :]
    return jnp.cos(ang_r), jnp.sin(ang_r), jnp.cos(ang_c), jnp.sin(ang_c)


def rotate(x, cos, sin):
    x1, x2 = jnp.split(x, 2, axis=-1)
    cos = cos[None, :, None, :]
    sin = sin[None, :, None, :]
    return jnp.concatenate([x1 * cos - x2 * sin, x1 * sin + x2 * cos], axis=-1)


def apply_axial_rope(x, tables):
    cr, sr, cc, scol = tables
    xf = x.astype(jnp.float32)
    xr, xc = jnp.split(xf, 2, axis=-1)
    return jnp.concatenate([rotate(xr, cr, sr), rotate(xc, cc, scol)], axis=-1).astype(x.dtype)


def gqa_core(q, k, v):
    B, Lq = q.shape[0], q.shape[1]
    G = N_HEADS // N_KV_HEADS
    qg = q.reshape(B, Lq, N_KV_HEADS, G, HEAD_DIM)
    s = jnp.einsum("bqkgd,bskd->bkgqs", qg, k).astype(jnp.float32) * (HEAD_DIM ** -0.5)
    p = jax.nn.softmax(s, axis=-1).astype(v.dtype)
    o = jnp.einsum("bkgqs,bskd->bqkgd", p, v)
    return o.reshape(B, Lq, N_HEADS * HEAD_DIM)


def qkv_proj(h, w_qkv, q_g, k_g):
    B, L, _ = h.shape
    qkv = h @ w_qkv
    q, k, v = jnp.split(qkv, [N_HEADS * HEAD_DIM, (N_HEADS + N_KV_HEADS) * HEAD_DIM], axis=-1)
    q = rms_norm(q.reshape(B, L, N_HEADS, HEAD_DIM), q_g)
    k = rms_norm(k.reshape(B, L, N_KV_HEADS, HEAD_DIM), k_g)
    v = v.reshape(B, L, N_KV_HEADS, HEAD_DIM)
    return q, k, v


def attn_mix(h_ctx, h_lat, w_qkv, w_o, q_g, k_g, ctx_out):
    B, S, _ = h_lat.shape
    qc, kc, vc = qkv_proj(h_ctx, w_qkv, q_g, k_g)
    ql, kl, vl = qkv_proj(h_lat, w_qkv, q_g, k_g)
    tables = axial_rope_tables(S)
    ql = apply_axial_rope(ql, tables)
    kl = apply_axial_rope(kl, tables)
    k_all = jnp.concatenate([kc, kl], axis=1)
    v_all = jnp.concatenate([vc, vl], axis=1)
    nb = S // Q_BLOCK
    qb = ql.reshape(B, nb, Q_BLOCK, N_HEADS, HEAD_DIM).transpose(1, 0, 2, 3, 4)
    ob = lax.map(lambda qq: gqa_core(qq, k_all, v_all), qb)
    y_lat = ob.transpose(1, 0, 2, 3).reshape(B, S, N_HEADS * HEAD_DIM) @ w_o
    y_ctx = gqa_core(qc, kc, vc) @ w_o if ctx_out else None
    return y_ctx, y_lat


def gmlp_mix(h, w_in, ln_g, ln_b, ws, bs, w_out):
    B, L, _ = h.shape
    z = jax.nn.gelu(h @ w_in)
    u, v = jnp.split(z, 2, axis=-1)
    v = layer_norm(v, ln_g, ln_b)
    vg = v.reshape(B, L // CHUNK, CHUNK, GMLP_GROUPS, GMLP_GW)
    sv = jnp.einsum("gqp,bnpgc->bnqgc", ws, vg) + bs.T[None, None, :, :, None]
    return (u * sv.reshape(B, L, GMLP_HALF)) @ w_out


def sq_relu_mlp(h, w1, w2):
    return jnp.square(jax.nn.relu(h @ w1)) @ w2


def setup_inputs(seed: int = 0) -> dict:
    key = jax.random.key(seed)
    ks = jax.random.split(key, 24)
    f32 = jnp.float32
    D = D_MODEL
    nP, nA, nG = n_layers_of(0), n_layers_of(1), n_layers_of(2)

    def nrm(k, shape, s):
        return jax.random.normal(k, shape, f32) * s

    return {
        "x": nrm(ks[0], (BATCH, SEQ, D), 1.0),
        "c": nrm(ks[1], (BATCH, D), 1.0),
        "ctx": nrm(ks[2], (BATCH, CTX_LEN, D), 1.0),
        "c_ctx": nrm(ks[3], (D,), 1.0),
        "ada_w": nrm(ks[4], (DEPTH, D, 6 * D), 0.5 * D ** -0.5),
        "ada_b": nrm(ks[5], (DEPTH, 6 * D), 0.02),
        "norm_g": 1.0 + nrm(ks[6], (DEPTH, 2, D), 0.02),
        "mlp_w1": nrm(ks[7], (DEPTH, D, D_FF), D ** -0.5),
        "mlp_w2": nrm(ks[8], (DEPTH, D_FF, D), D_FF ** -0.5),
        "pool_w": nrm(ks[9], (nP, POOL_GROUPS, POOL_GW, POOL_GW), POOL_GW ** -0.5),
        "pool_scale": 1.0 + nrm(ks[10], (nP, D), 0.02),
        "attn_w_qkv": nrm(ks[11], (nA, D, QKV_WIDTH), D ** -0.5),
        "attn_w_o": nrm(ks[12], (nA, N_HEADS * HEAD_DIM, D), (N_HEADS * HEAD_DIM) ** -0.5),
        "attn_q_g": 1.0 + nrm(ks[13], (nA, HEAD_DIM), 0.02),
        "attn_k_g": 1.0 + nrm(ks[14], (nA, HEAD_DIM), 0.02),
        "gm_w_in": nrm(ks[15], (nG, D, 2 * GMLP_HALF), D ** -0.5),
        "gm_ln_g": 1.0 + nrm(ks[16], (nG, GMLP_HALF), 0.02),
        "gm_ln_b": nrm(ks[17], (nG, GMLP_HALF), 0.02),
        "gm_ws": nrm(ks[18], (nG, GMLP_GROUPS, CHUNK, CHUNK), CHUNK ** -0.5),
        "gm_bs": nrm(ks[19], (nG, GMLP_GROUPS, CHUNK), 0.02),
        "gm_w_out": nrm(ks[20], (nG, GMLP_HALF, D), GMLP_HALF ** -0.5),
        "final_g": 1.0 + nrm(ks[21], (D,), 0.02),
    }


def reference(x, c, ctx, c_ctx, ada_w, ada_b, norm_g, mlp_w1, mlp_w2, pool_w, pool_scale,
              attn_w_qkv, attn_w_o, attn_q_g, attn_k_g, gm_w_in, gm_ln_g, gm_ln_b, gm_ws, gm_bs,
              gm_w_out, final_g):
    last_ctx_read = max([i for i in range(DEPTH) if i % N_MIXERS == 1], default=-1)
    s_lat = jax.nn.silu(c)
    s_ctx = jax.nn.silu(c_ctx)[None, :]
    h_lat, h_ctx = x, ctx
    for i in range(DEPTH):
        kind, j = i % N_MIXERS, i // N_MIXERS
        ctx_in = i <= last_ctx_read
        ctx_out = i < last_ctx_read
        sh1, sc1, g1, sh2, sc2, g2 = jnp.split(s_lat @ ada_w[i] + ada_b[i], 6, axis=-1)
        a_l = modulate(rms_norm(h_lat, norm_g[i, 0]), sh1, sc1)
        if ctx_in:
            csh1, csc1, cg1, csh2, csc2, cg2 = jnp.split(s_ctx @ ada_w[i] + ada_b[i], 6, axis=-1)
            a_c = modulate(rms_norm(h_ctx, norm_g[i, 0]), csh1, csc1)
        y_c = None
        if kind == 0:
            y_l = pool_mix(a_l, pool_w[j], pool_scale[j])
            if ctx_out:
                y_c = pool_mix(a_c, pool_w[j], pool_scale[j])
        elif kind == 1:
            y_c, y_l = attn_mix(a_c, a_l, attn_w_qkv[j], attn_w_o[j], attn_q_g[j], attn_k_g[j], ctx_out)
        else:
            y_l = gmlp_mix(a_l, gm_w_in[j], gm_ln_g[j], gm_ln_b[j], gm_ws[j], gm_bs[j], gm_w_out[j])
            if ctx_out:
                y_c = gmlp_mix(a_c, gm_w_in[j], gm_ln_g[j], gm_ln_b[j], gm_ws[j], gm_bs[j], gm_w_out[j])
        h_lat = h_lat + g1[:, None, :] * y_l
        m_l = modulate(rms_norm(h_lat, norm_g[i, 1]), sh2, sc2)
        h_lat = h_lat + g2[:, None, :] * sq_relu_mlp(m_l, mlp_w1[i], mlp_w2[i])
        if ctx_out:
            h_ctx = h_ctx + cg1[:, None, :] * y_c
            m_c = modulate(rms_norm(h_ctx, norm_g[i, 1]), csh2, csc2)
            h_ctx = h_ctx + cg2[:, None, :] * sq_relu_mlp(m_c, mlp_w1[i], mlp_w2[i])
    return rms_norm(h_lat, final_g)
```

```cpp
#include <hip/hip_runtime.h>
#include <hip/hip_cooperative_groups.h>
#include <hip/hip_bf16.h>
#include <cstdio>
#include <cstdint>
namespace cg = cooperative_groups;

#ifndef PROBE_MASK
#define PROBE_MASK 0u
#endif
#ifndef MK_N_LAUNCHES
#define MK_N_LAUNCHES 1
#endif

constexpr int DM = 1024, SEQ = 8192, NB = 2, CTXL = 256, DFF = 4096, DEPTH = 4;
constexpr int MLAT = NB * SEQ;
constexpr int MCTX = NB * CTXL;
constexpr int MALL = MLAT + MCTX;
constexpr int SKV = CTXL + SEQ;
constexpr float EPS = 1e-6f;

namespace pg8 {
#define PG8_LAS __attribute__((address_space(3)))
typedef unsigned short bf16_t;
typedef short bf16x8 __attribute__((ext_vector_type(8)));
typedef float f32x4 __attribute__((ext_vector_type(4)));
typedef float f32x2 __attribute__((ext_vector_type(2)));
typedef unsigned u32x4 __attribute__((ext_vector_type(4)));
typedef unsigned u32x2 __attribute__((ext_vector_type(2)));
constexpr int BM = 256, BK = 64, HALF = 128, HTB = HALF * BK * 2, STAGE_BYTES = 8 * HTB, NXCD = 8, WGM = 8;

__host__ __device__ __forceinline__ int lds_byte(int r, int c) { const int st = (r >> 4) * 2 + (c >> 5), rr = r & 15, cc = c & 31, ob = rr * 64 + cc * 2; return st * 1024 + (ob ^ (((ob >> 9) & 1) << 5)); }
__host__ __device__ __forceinline__ void stage_rc(int b, int& R, int& C) { const int st = b / 1024, sb = b % 1024, swz = sb ^ (((sb >> 9) & 1) << 5); R = (st >> 1) * 16 + swz / 64; C = (st & 1) * 32 + (swz % 64) / 2; }
__host__ __device__ __forceinline__ int perm32(int rho) { const int n = rho >> 4, i = rho & 15; return 8 * (i >> 2) + 4 * n + (i & 3); }

struct Unit { int pm, pn, ks; };
struct Gemm { const bf16_t* A; const bf16_t* Bt; int M, N, K, lda, a_pn_off, ldb; };

struct StaticOrder {
    int nM, nN, nwg, G, c;
    __host__ __device__ void init(int M, int N, int G_, int c_) { nM = M / BM; nN = N / BM; nwg = nM * nN; G = G_; c = c_; }
    __host__ __device__ bool next(int i, Unit& u) const {
        const long L = (long)i * G + c; if (L >= nwg) return false;
        int wgid = (int)L; { const int q = nwg / NXCD, r = nwg % NXCD, xcd = wgid % NXCD, off = wgid / NXCD; wgid = (xcd < r ? xcd * (q + 1) : r * (q + 1) + (xcd - r) * q) + off; }
        const int nig = WGM * nN, gid = wgid / nig, fm = gid * WGM, gsz = (nM - fm) < WGM ? (nM - fm) : WGM;
        u.pm = fm + ((wgid % nig) % gsz); u.pn = (wgid % nig) / gsz; return true;
    }
    __device__ __forceinline__ size_t koff(const Unit&) const { return 0; }
    __device__ __forceinline__ int nt(const Unit&, int d) const { return d; }
};
struct SplitOrder {
    StaticOrder so; int G, c;
    __device__ void init(int G_, int c_) { so.init(MLAT, DM, G_, c_); G = G_; c = c_; }
    __device__ bool next(int i, Unit& u) const {
        const long L = (long)i * G + c;
        if (L < so.nwg) { const bool r = so.next(i, u); u.ks = 0; return r; }
        const int j = (int)(L - so.nwg); if (j >= 32) return false;
        u.pm = 64 + (j >> 4); u.pn = (j >> 2) & 3; u.ks = j & 3; return true;
    }
    __device__ __forceinline__ size_t koff(const Unit& u) const { return u.pm >= 64 ? (size_t)u.ks * 2048 : 0; }
    __device__ __forceinline__ int nt(const Unit& u, int d) const { return u.pm >= 64 ? 16 : d; }
};

__device__ __forceinline__ unsigned cvt_pk_bf16(float lo, float hi) { unsigned r; asm volatile("v_cvt_pk_bf16_f32 %0, %1, %2" : "=v"(r) : "v"(lo), "v"(hi)); return r; }
__device__ __forceinline__ float gelu_tanh(float x) {
    const float u = x * (0.7978845608f + 0.0356774081f * x * x);
    const float e = __builtin_amdgcn_exp2f(u * 2.8853900818f);
    return x - x * __builtin_amdgcn_rcpf(e + 1.0f);
}

template <int ACT  > struct EpiBf16 {
    static constexpr bool PERM = true;
    bf16_t* O; int ldc; float* stats; const float* ssq; const float* bias; int nbias;
    __device__ __forceinline__ void operator()(const f32x4 (&acc)[2][2][4][2], const Unit& u, int wr, int wc, int fr, int fq) const {
        const int rowt = u.pm * BM, b = rowt >= MLAT ? 2 : (rowt >> 13);
        const int row0 = rowt + wr * 64 + fr, col0 = u.pn * BM + wc * 32 + 8 * fq;
        f32x4 bv[2][2];
#pragma unroll
        for (int bj = 0; bj < 2; ++bj)
#pragma unroll
            for (int n = 0; n < 2; ++n) bv[bj][n] = *(const f32x4*)(bias + (size_t)b * nbias + col0 + bj * HALF + 4 * n);
        float rsv[2][4];
        { f32x4 pq[2][4];
#pragma unroll
          for (int ai = 0; ai < 2; ++ai)
#pragma unroll
              for (int m = 0; m < 4; ++m) pq[ai][m] = *(const f32x4*)(ssq + (size_t)(row0 + ai * HALF + m * 16) * 16 + 4 * fq);
#pragma unroll
          for (int ai = 0; ai < 2; ++ai)
#pragma unroll
              for (int m = 0; m < 4; ++m) { float t = (pq[ai][m][0] + pq[ai][m][1]) + (pq[ai][m][2] + pq[ai][m][3]); t += __shfl_xor(t, 16); t += __shfl_xor(t, 32);
                  rsv[ai][m] = rsqrtf(t * (1.f / DM) + EPS); } }
#pragma unroll
        for (int ai = 0; ai < 2; ++ai)
#pragma unroll
            for (int m = 0; m < 4; ++m) { const int row = row0 + ai * HALF + m * 16; bf16_t* rowp = O + (size_t)row * ldc + col0; float s = 0.f, q = 0.f;
                const float rstd = rsv[ai][m];
#pragma unroll
                for (int bj = 0; bj < 2; ++bj) { f32x4 v0 = acc[ai][bj][m][0] * rstd + bv[bj][0], v1 = acc[ai][bj][m][1] * rstd + bv[bj][1];
                    if (ACT == 1) {
#pragma unroll
                        for (int e = 0; e < 4; ++e) { const float a = fmaxf(v0[e], 0.f), b2 = fmaxf(v1[e], 0.f); v0[e] = a * a; v1[e] = b2 * b2; } }
                    if (ACT == 2) {
#pragma unroll
                        for (int e = 0; e < 4; ++e) { v0[e] = gelu_tanh(v0[e]); v1[e] = gelu_tanh(v1[e]); s += v0[e] + v1[e]; q += v0[e] * v0[e] + v1[e] * v1[e]; } }
                    u32x4 w; w.x = cvt_pk_bf16(v0[0], v0[1]); w.y = cvt_pk_bf16(v0[2], v0[3]); w.z = cvt_pk_bf16(v1[0], v1[1]); w.w = cvt_pk_bf16(v1[2], v1[3]);
                    *(u32x4*)(rowp + bj * HALF) = w; }
                if (ACT == 2) { if (u.pn >= 8) { s += __shfl_xor(s, 16); s += __shfl_xor(s, 32); q += __shfl_xor(q, 16); q += __shfl_xor(q, 32);
                    if (fq == 0) *(f32x2*)(stats + ((size_t)row * 32 + (u.pn - 8) * 4 + wc) * 2) = (f32x2){s, q}; } }
            }
    }
};
struct EpiRes {
    static constexpr bool PERM = true;
    const float* base_lat; const float* base_ctx;   bf16_t* h16; const float* gate;   const float* cs;
    bf16_t* hb; const float* wn_g; const float* wn_sc;   float* ssq;
    __device__ __forceinline__ void operator()(const f32x4 (&acc)[2][2][4][2], const Unit& u, int wr, int wc, int fr, int fq) const {
        asm volatile("" : "+v"(fr), "+v"(fq));
        const int rowt = u.pm * BM, b = rowt >= MLAT ? 2 : (rowt >> 13);
        const float* gp = gate + b * 6144; const int col0 = u.pn * BM + wc * 32 + 8 * fq;
        f32x4 gv[2][2], wv[2][2];
#pragma unroll
        for (int bj = 0; bj < 2; ++bj)
#pragma unroll
            for (int n = 0; n < 2; ++n) { gv[bj][n] = *(const f32x4*)(gp + col0 + bj * HALF + n * 4); if (cs) gv[bj][n] = gv[bj][n] * *(const f32x4*)(cs + col0 + bj * HALF + n * 4);
                if (hb) wv[bj][n] = *(const f32x4*)(wn_g + col0 + bj * HALF + n * 4) * (*(const f32x4*)(wn_sc + b * 6144 + col0 + bj * HALF + n * 4) + 1.0f); }
        const float* bb = base_lat ? (rowt >= MLAT ? base_ctx + (size_t)(rowt - MLAT) * DM : base_lat + (size_t)rowt * DM) : nullptr;
#pragma unroll
        for (int ai = 0; ai < 2; ++ai) {
            u32x4 raw[4][2];
#pragma unroll
            for (int m = 0; m < 4; ++m)
#pragma unroll
                for (int bj = 0; bj < 2; ++bj) raw[m][bj] = *(const u32x4*)(h16 + (size_t)rowt * DM + (size_t)(wr * 64 + fr + ai * HALF + m * 16) * DM + col0 + bj * HALF);
#pragma unroll
            for (int m = 0; m < 4; ++m) { const int rl = wr * 64 + fr + ai * HALF + m * 16; const size_t off = (size_t)rl * DM + col0; float sq = 0.f;
                bf16_t* hrow = h16 + (size_t)rowt * DM + off;
#pragma unroll
                for (int bj = 0; bj < 2; ++bj) { f32x4 b0, b1;
                    if (bb) { b0 = *(const f32x4*)(bb + off + bj * HALF); b1 = *(const f32x4*)(bb + off + bj * HALF + 4); }
                    else { const u32x4 r = raw[m][bj];
                        b0 = (f32x4){__uint_as_float(r.x << 16), __uint_as_float(r.x & 0xffff0000u), __uint_as_float(r.y << 16), __uint_as_float(r.y & 0xffff0000u)};
                        b1 = (f32x4){__uint_as_float(r.z << 16), __uint_as_float(r.z & 0xffff0000u), __uint_as_float(r.w << 16), __uint_as_float(r.w & 0xffff0000u)}; }
                    const f32x4 o0 = b0 + gv[bj][0] * acc[ai][bj][m][0], o1 = b1 + gv[bj][1] * acc[ai][bj][m][1];
                    u32x4 w; w.x = cvt_pk_bf16(o0[0], o0[1]); w.y = cvt_pk_bf16(o0[2], o0[3]); w.z = cvt_pk_bf16(o1[0], o1[1]); w.w = cvt_pk_bf16(o1[2], o1[3]);
                    *(u32x4*)(hrow + bj * HALF) = w;
                    sq += ((o0[0] * o0[0] + o0[1] * o0[1]) + (o0[2] * o0[2] + o0[3] * o0[3])) + ((o1[0] * o1[0] + o1[1] * o1[1]) + (o1[2] * o1[2] + o1[3] * o1[3]));
                    if (hb) { const f32x4 y0 = o0 * wv[bj][0], y1 = o1 * wv[bj][1]; u32x4 z; z.x = cvt_pk_bf16(y0[0], y0[1]); z.y = cvt_pk_bf16(y0[2], y0[3]); z.z = cvt_pk_bf16(y1[0], y1[1]); z.w = cvt_pk_bf16(y1[2], y1[3]);
                        *(u32x4*)(hb + (size_t)rowt * DM + off + bj * HALF) = z; } }
                if (ssq) { sq += __shfl_xor(sq, 16); sq += __shfl_xor(sq, 32); if (fq == 0) ssq[(size_t)(rowt + rl) * 16 + u.pn * 4 + wc] = sq; } }
        }
    }
};

struct EpiResSplit {
    static constexpr bool PERM = true;
    EpiRes base; float* cacc;
    __device__ __forceinline__ void operator()(const f32x4 (&acc)[2][2][4][2], const Unit& u, int wr, int wc, int fr, int fq) const {
        if (u.pm < 64) { base(acc, u, wr, wc, fr, fq); return; }
        asm volatile("" : "+v"(fr), "+v"(fq));
        const int rowt = u.pm * BM, col0 = u.pn * BM + wc * 32 + 8 * fq;
        const float* gp = base.gate + 2 * 6144;
        float* ob = cacc + (size_t)u.ks * MCTX * DM + (size_t)(rowt - MLAT) * DM;
        f32x4 gv[2][2];
#pragma unroll
        for (int bj = 0; bj < 2; ++bj)
#pragma unroll
            for (int n = 0; n < 2; ++n) gv[bj][n] = *(const f32x4*)(gp + col0 + bj * HALF + n * 4);
#pragma unroll
        for (int ai = 0; ai < 2; ++ai)
#pragma unroll
            for (int m = 0; m < 4; ++m) { float* o = ob + (size_t)(wr * 64 + fr + ai * HALF + m * 16) * DM + col0; asm volatile("" : "+v"(o));
#pragma unroll
                for (int bj = 0; bj < 2; ++bj)
#pragma unroll
                    for (int n = 0; n < 2; ++n) *(f32x4*)(o + bj * HALF + n * 4) = gv[bj][n] * acc[ai][bj][m][n]; }
    }
};

struct EpiQKV {
    static constexpr bool PERM = true;
    bf16_t* Q; bf16_t* K; bf16_t* V; const float* ssq; const float* bias; const float* qg; const float* kg; PG8_LAS float* P;
    __device__ __forceinline__ void operator()(f32x4 (&acc)[2][2][4][2], const Unit& u, int wr, int wc, int fr, int fq) const {
        asm volatile("" : "+v"(fr), "+v"(fq));
        const int rowt = u.pm * BM, b = rowt >= MLAT ? 2 : (rowt >> 13); const bool is_lat = rowt < MLAT;
        if (!is_lat && u.pn < 4) return;
        const int col0 = u.pn * BM + wc * 32 + 8 * fq;
        const bool qk = u.pn < 6;
        {   f32x4 bv[2][2];
#pragma unroll
            for (int bj = 0; bj < 2; ++bj)
#pragma unroll
                for (int n = 0; n < 2; ++n) bv[bj][n] = *(const f32x4*)(bias + (size_t)b * 2048 + col0 + bj * HALF + 4 * n);
            float rsv[2][4];
            { f32x4 pq[2][4];
#pragma unroll
              for (int ai = 0; ai < 2; ++ai)
#pragma unroll
                  for (int m = 0; m < 4; ++m) pq[ai][m] = *(const f32x4*)(ssq + (size_t)(rowt + wr * 64 + fr + ai * HALF + m * 16) * 16 + 4 * fq);
#pragma unroll
              for (int ai = 0; ai < 2; ++ai)
#pragma unroll
                  for (int m = 0; m < 4; ++m) { float t = (pq[ai][m][0] + pq[ai][m][1]) + (pq[ai][m][2] + pq[ai][m][3]); t += __shfl_xor(t, 16); t += __shfl_xor(t, 32);
                      rsv[ai][m] = rsqrtf(t * (1.f / DM) + EPS); } }
#pragma unroll
            for (int ai = 0; ai < 2; ++ai)
#pragma unroll
                for (int m = 0; m < 4; ++m) { const int rl = wr * 64 + fr + ai * HALF + m * 16;
                    const float rstd = rsv[ai][m];
#pragma unroll
                    for (int bj = 0; bj < 2; ++bj) { const f32x4 v0 = acc[ai][bj][m][0] * rstd + bv[bj][0], v1 = acc[ai][bj][m][1] * rstd + bv[bj][1];
                        acc[ai][bj][m][0] = v0; acc[ai][bj][m][1] = v1;
                        if (qk) { float sq = ((v0[0] * v0[0] + v0[1] * v0[1]) + (v0[2] * v0[2] + v0[3] * v0[3])) + ((v1[0] * v1[0] + v1[1] * v1[1]) + (v1[2] * v1[2] + v1[3] * v1[3]));
                            sq += __shfl_xor(sq, 16); sq += __shfl_xor(sq, 32); if (fq == 0) P[(rl * 2 + bj) * 4 + wc] = sq; } } }
        }
        if (qk) { asm volatile("s_waitcnt lgkmcnt(0)" ::: "memory"); __builtin_amdgcn_s_barrier(); asm volatile("" ::: "memory"); }
        float gq[2][4], inv[2][2];
        { const float* gsrc = u.pn < 4 ? qg : kg;
#pragma unroll
          for (int n = 0; n < 2; ++n) {
#pragma unroll
            for (int e = 0; e < 4; ++e) { const int p = wc * 32 + 8 * fq + 4 * n + e; gq[n][e] = gsrc[(p >> 6) * 64 + (p & 1) * 32 + ((p & 63) >> 1)]; }
#pragma unroll
            for (int pr = 0; pr < 2; ++pr) inv[n][pr] = __builtin_amdgcn_exp2f(-(float)(16 * (wc & 1) + 4 * fq + 2 * n + pr) * 0.4152410118609203f); } }
        const int headbase = (u.pn & 1) * 2;
#pragma unroll
        for (int ai = 0; ai < 2; ++ai)
#pragma unroll
            for (int m = 0; m < 4; ++m) { const int rl = wr * 64 + fr + ai * HALF + m * 16, row = rowt + rl;
                int kvrow; float cs[2][2], sn[2][2];
                if (is_lat) { const int t = row & (SEQ - 1); kvrow = b * SKV + CTXL + t; const float pos = (float)((wc >> 1) ? (t & 63) : (t >> 6));
#pragma unroll
                    for (int n = 0; n < 2; ++n)
#pragma unroll
                        for (int pr = 0; pr < 2; ++pr) { const float a = pos * inv[n][pr]; cs[n][pr] = __cosf(a); sn[n][pr] = __sinf(a); } }
                else { kvrow = ((row - MLAT) >> 8) * SKV + ((row - MLAT) & (CTXL - 1));
#pragma unroll
                    for (int n = 0; n < 2; ++n)
#pragma unroll
                        for (int pr = 0; pr < 2; ++pr) { cs[n][pr] = 1.f; sn[n][pr] = 0.f; } }
#pragma unroll
                for (int bj = 0; bj < 2; ++bj) { f32x4 v0 = acc[ai][bj][m][0], v1 = acc[ai][bj][m][1]; bf16_t* dst;
                    if (qk) { const f32x4 pt = *(const PG8_LAS f32x4*)(P + (rl * 2 + bj) * 4);
                        const float hr = rsqrtf(((pt[0] + pt[1]) + (pt[2] + pt[3])) * (1.f / 128.f) + EPS);
#pragma unroll
                        for (int e = 0; e < 4; ++e) { v0[e] = v0[e] * hr * gq[0][e]; v1[e] = v1[e] * hr * gq[1][e]; }
                        const f32x4 r0 = {v0[0] * cs[0][0] - v0[1] * sn[0][0], v0[0] * sn[0][0] + v0[1] * cs[0][0], v0[2] * cs[0][1] - v0[3] * sn[0][1], v0[2] * sn[0][1] + v0[3] * cs[0][1]};
                        const f32x4 r1 = {v1[0] * cs[1][0] - v1[1] * sn[1][0], v1[0] * sn[1][0] + v1[1] * cs[1][0], v1[2] * cs[1][1] - v1[3] * sn[1][1], v1[2] * sn[1][1] + v1[3] * cs[1][1]};
                        v0 = r0; v1 = r1;
                        dst = u.pn < 4 ? Q + (size_t)row * DM + (u.pn * 2 + bj) * 128 : K + (size_t)kvrow * 512 + ((u.pn - 4) * 2 + bj) * 128;
                    } else dst = V + (size_t)kvrow * 512 + ((u.pn - 6) * 2 + bj) * 128;
                    u32x4 w; w.x = cvt_pk_bf16(v0[0], v0[1]); w.y = cvt_pk_bf16(v0[2], v0[3]); w.z = cvt_pk_bf16(v1[0], v1[1]); w.w = cvt_pk_bf16(v1[2], v1[3]);
                    *(u32x4*)(dst + wc * 32 + 8 * fq) = w; } }
        (void)headbase;
    }
};

template <class Epi, class Sched>
__device__ __forceinline__ void gemm_phase(PG8_LAS unsigned char* lds, const Gemm g, const Sched& S, const Epi& E, const int tid) {
    const int wid = __builtin_amdgcn_readfirstlane(tid >> 6), lane = tid & 63, wr = wid >> 2, wc = wid & 3, fr = lane & 15, fq = lane >> 4;
    const int K = g.K, nt = K / BK, lda = g.lda, ldb = g.ldb;
    unsigned voffA[2], voffB[2];
#pragma unroll
    for (int i = 0; i < 2; ++i) { int R, C; stage_rc(tid * 16 + i * 8192, R, C); const int Rb = Epi::PERM ? ((R & ~31) + perm32(R & 31)) : R;
        voffA[i] = (unsigned)(R * lda + C) * 2u; voffB[i] = (unsigned)(Rb * ldb + C) * 2u; }
    const size_t kstep = (size_t)(BK * 2);
    const size_t hstepA = (size_t)HALF * lda * 2, hstepB = (size_t)HALF * ldb * 2;
    const size_t tstepA = 2 * hstepA, tstepB = 2 * hstepB;
    const unsigned ldsw = (unsigned)wid * 1024u;
    const int aoff = lds_byte(wr * 64 + fr, fq * 8), boff = lds_byte(wc * 32 + fr, fq * 8);
#define PG8_SA(b, h) (((b) * 2 + (h)) * HTB)
#define PG8_SB(b, h) ((4 + (b) * 2 + (h)) * HTB)
#define PG8_STAGE(bufoff, gbase, voff) do { _Pragma("unroll") for (int _i = 0; _i < 2; ++_i) \
        __builtin_amdgcn_global_load_lds((const unsigned*)((const char*)(gbase) + (voff)[_i]), (PG8_LAS unsigned*)(lds + (bufoff) + ldsw + _i * 8192), 16, 0, 0); } while (0)
#define PG8_LDA(dst, b, h) do { _Pragma("unroll") for (int m = 0; m < 4; ++m) _Pragma("unroll") for (int k = 0; k < 2; ++k) dst[m][k] = *(const PG8_LAS bf16x8*)(lds + PG8_SA(b, h) + aoff + m * 2048 + k * 1024); } while (0)
#define PG8_LDB(dst, b, h) do { _Pragma("unroll") for (int n = 0; n < 2; ++n) _Pragma("unroll") for (int k = 0; k < 2; ++k) dst[n][k] = *(const PG8_LAS bf16x8*)(lds + PG8_SB(b, h) + boff + n * 2048 + k * 1024); } while (0)
#define PG8_MMA(ai, bj, At, Bt) do { __builtin_amdgcn_s_setprio(1); _Pragma("unroll") for (int m = 0; m < 4; ++m) _Pragma("unroll") for (int n = 0; n < 2; ++n) _Pragma("unroll") for (int k = 0; k < 2; ++k) \
        acc[ai][bj][m][n] = __builtin_amdgcn_mfma_f32_16x16x32_bf16(Bt[n][k], At[m][k], acc[ai][bj][m][n], 0, 0, 0); __builtin_amdgcn_s_setprio(0); } while (0)
#define PG8_WAIT_V(n) asm volatile("s_waitcnt vmcnt(" #n ")" ::: "memory")
#define PG8_WAIT_L(n) asm volatile("s_waitcnt lgkmcnt(" #n ")" ::: "memory")
#define PG8_BAR __builtin_amdgcn_s_barrier()
#define PG8_SCHED __builtin_amdgcn_sched_barrier(0)
    Unit cur, nxt; int ui = 0;
    if (!S.next(0, cur)) return;
    f32x4 acc[2][2][4][2];
#pragma unroll
    for (int a = 0; a < 2; ++a)
#pragma unroll
        for (int b = 0; b < 2; ++b)
#pragma unroll
            for (int m = 0; m < 4; ++m)
#pragma unroll
                for (int n = 0; n < 2; ++n) acc[a][b][m][n] = (f32x4){0.f, 0.f, 0.f, 0.f};
    bf16x8 At[4][2], B0[2][2], B1[2][2];
    const char* cA = (const char*)g.A + (size_t)cur.pm * tstepA + (size_t)cur.pn * g.a_pn_off + S.koff(cur); const char* cB = (const char*)g.Bt + (size_t)cur.pn * tstepB + S.koff(cur);
    PG8_STAGE(PG8_SB(0, 0), cB, voffB); PG8_STAGE(PG8_SB(0, 1), cB + hstepB, voffB); PG8_STAGE(PG8_SA(0, 0), cA, voffA); PG8_STAGE(PG8_SA(0, 1), cA + hstepA, voffA);
    if (wr == 1) PG8_BAR;
    PG8_WAIT_V(2); PG8_BAR;
    PG8_STAGE(PG8_SB(1, 0), cB + kstep, voffB); PG8_STAGE(PG8_SA(1, 0), cA + kstep, voffA); PG8_STAGE(PG8_SB(1, 1), cB + hstepB + kstep, voffB);
    PG8_WAIT_V(6); PG8_BAR;
    for (;;) {
        const bool has_next = S.next(ui + 1, nxt);
        const char* nA = has_next ? (const char*)g.A + (size_t)nxt.pm * tstepA + (size_t)nxt.pn * g.a_pn_off + S.koff(nxt) : cA; const char* nB = has_next ? (const char*)g.Bt + (size_t)nxt.pn * tstepB + S.koff(nxt) : cB;
        const int ntc = S.nt(cur, nt);
        for (int t = 0; t < ntc; t += 2) {
            const bool last = (t == ntc - 2);
            const char* a1 = cA + (size_t)(t + 1) * kstep;
            const char* a2 = last ? nA : cA + (size_t)(t + 2) * kstep; const char* b2 = last ? nB : cB + (size_t)(t + 2) * kstep;
            const char* a3 = a2 + kstep; const char* b3 = b2 + kstep;
            PG8_LDB(B0, 0, 0); PG8_LDB(B1, 0, 1); PG8_SCHED; PG8_LDA(At, 0, 0); PG8_STAGE(PG8_SA(1, 1), a1 + hstepA, voffA);
            PG8_WAIT_V(8); PG8_WAIT_L(0); PG8_BAR; PG8_MMA(0, 0, At, B0); PG8_MMA(0, 1, At, B1); PG8_BAR; PG8_SCHED;
            PG8_LDA(At, 0, 1); PG8_STAGE(PG8_SB(0, 0), b2, voffB); PG8_STAGE(PG8_SB(0, 1), b2 + hstepB, voffB); PG8_STAGE(PG8_SA(0, 0), a2, voffA);
            PG8_WAIT_V(8); PG8_WAIT_L(0); PG8_BAR; PG8_MMA(1, 0, At, B0); PG8_MMA(1, 1, At, B1); PG8_BAR; PG8_SCHED;
            PG8_LDB(B0, 1, 0); PG8_LDB(B1, 1, 1); PG8_SCHED; PG8_LDA(At, 1, 0); PG8_STAGE(PG8_SA(0, 1), a2 + hstepA, voffA);
            PG8_WAIT_V(8); PG8_WAIT_L(0); PG8_BAR; PG8_MMA(0, 0, At, B0); PG8_MMA(0, 1, At, B1); PG8_BAR; PG8_SCHED;
            PG8_LDA(At, 1, 1); PG8_STAGE(PG8_SB(1, 0), b3, voffB); PG8_STAGE(PG8_SB(1, 1), b3 + hstepB, voffB); PG8_STAGE(PG8_SA(1, 0), a3, voffA);
            PG8_WAIT_V(8); PG8_WAIT_L(0); PG8_BAR; PG8_MMA(1, 0, At, B0); PG8_MMA(1, 1, At, B1); PG8_BAR; PG8_SCHED;
        }
        if (wr == 0) PG8_BAR;
        E(acc, cur, wr, wc, fr, fq);
        if (!has_next) break;
#pragma unroll
        for (int a = 0; a < 2; ++a)
#pragma unroll
            for (int b = 0; b < 2; ++b)
#pragma unroll
                for (int m = 0; m < 4; ++m)
#pragma unroll
                    for (int n = 0; n < 2; ++n) acc[a][b][m][n] = (f32x4){0.f, 0.f, 0.f, 0.f};
        cur = nxt; cA = nA; cB = nB; ++ui;
        if (wr == 1) PG8_BAR;
    }
    PG8_WAIT_V(0);
    PG8_BAR;
#undef PG8_SA
#undef PG8_SB
#undef PG8_STAGE
#undef PG8_LDA
#undef PG8_LDB
#undef PG8_MMA
#undef PG8_WAIT_V
#undef PG8_WAIT_L
#undef PG8_BAR
#undef PG8_SCHED
}
}

namespace attn {
using bf16 = __hip_bfloat16;
constexpr int D = 128, NW = 8, QBLK = 32, KVBLK = 64;
constexpr float SCALE = 0.088388347648318440f;
constexpr float THR = 8.f;
constexpr int SDEPTH = 2;
constexpr int LDQ = 1024, LDK = 512, LDO = 1024;
constexpr size_t SHM_V = KVBLK * D * 2, SHM_K = KVBLK * D * 2, SHM_ATTN = 2 * SHM_V + 2 * SHM_K + NW * 64 * 4;
using bf16x8 = __attribute__((ext_vector_type(8))) short;
using s16x4  = __attribute__((ext_vector_type(4))) short;
using f32x16 = __attribute__((ext_vector_type(16))) float;
using u32x4  = __attribute__((ext_vector_type(4))) unsigned;
#define KSWZ(row, colB) ((row) * 256 + ((colB) ^ (((row) & 7) << 4)))
#define SBAR() __builtin_amdgcn_sched_barrier(0)
__device__ __forceinline__ int crow(int r, int hi) { return (r & 3) + 8 * (r >> 2) + 4 * hi; }
__device__ __forceinline__ unsigned cvtpk(float lo, float hi) { unsigned r; asm volatile("v_cvt_pk_bf16_f32 %0, %1, %2" : "=v"(r) : "v"(lo), "v"(hi)); return r; }
__device__ __forceinline__ bf16x8 ld8(const bf16* p) { return *reinterpret_cast<const bf16x8*>(p); }

__device__ __forceinline__ void partialSM(f32x16& p0, f32x16& p1, float mnC) {
  constexpr float C = SCALE * 1.4426950408889634f;
#pragma unroll
  for (int r = 0; r < 16; ++r) p0[r] = fmaf(p0[r], C, mnC);
#pragma unroll
  for (int r = 0; r < 16; ++r) p1[r] = fmaf(p1[r], C, mnC);
#pragma unroll
  for (int r = 0; r < 16; ++r) p0[r] = __builtin_amdgcn_exp2f(p0[r]);
}
__device__ __forceinline__ void finishSM(f32x16& p0, f32x16& p1, float& l_reg, bf16x8& pa0, bf16x8& pa1, bf16x8& pa2, bf16x8& pa3) {
#pragma unroll
  for (int r = 0; r < 16; ++r) p1[r] = __builtin_amdgcn_exp2f(p1[r]);
  float ps = 0;
#pragma unroll
  for (int r = 0; r < 16; ++r) ps += p0[r];
#pragma unroll
  for (int r = 0; r < 16; ++r) ps += p1[r];
  l_reg += ps;
#define PK4(P, BASE, OUT) do { unsigned a0 = cvtpk(P[BASE + 0], P[BASE + 1]), a1 = cvtpk(P[BASE + 2], P[BASE + 3]);   \
    unsigned b0 = cvtpk(P[BASE + 4], P[BASE + 5]), b1 = cvtpk(P[BASE + 6], P[BASE + 7]);                              \
    auto r0 = __builtin_amdgcn_permlane32_swap(a0, b0, false, false); auto r1 = __builtin_amdgcn_permlane32_swap(a1, b1, false, false); \
    u32x4 w = {r0[0], r1[0], r0[1], r1[1]}; OUT = *reinterpret_cast<bf16x8*>(&w); } while (0)
  PK4(p0, 0, pa0); PK4(p0, 8, pa1); PK4(p1, 0, pa2); PK4(p1, 8, pa3);
#undef PK4
}
__device__ __forceinline__ void qkt(f32x16& p0, f32x16& p1, const bf16* Ks, const bf16x8* qr, int r32, int hi) {
  p0 = f32x16{}; p1 = f32x16{};
#pragma unroll
  for (int d0 = 0; d0 < 8; ++d0) { int cb = (d0 * 16 + hi * 8) * 2;
    bf16x8 b0 = *reinterpret_cast<const bf16x8*>((const char*)Ks + KSWZ(r32, cb));
    bf16x8 b1 = *reinterpret_cast<const bf16x8*>((const char*)Ks + KSWZ(32 + r32, cb));
    p0 = __builtin_amdgcn_mfma_f32_32x32x16_bf16(b0, qr[d0], p0, 0, 0, 0);
    p1 = __builtin_amdgcn_mfma_f32_32x32x16_bf16(b1, qr[d0], p1, 0, 0, 0); }
}
__device__ __forceinline__ int v_st(int k, int c) { const int kk = (k & ~0xC) | ((k & 4) << 1) | ((k & 8) >> 1); return ((kk >> 3) * 4 + (c >> 5)) * 512 + ((kk & 7) * 32 + (c & 31)) * 2; }
__device__ __forceinline__ int v_rd_base(int lane) { return ((lane & 3) << 3) | (((lane >> 2) & 3) << 6) | (((lane >> 4) & 1) << 5) | (((lane >> 5) & 1) << 8); }
constexpr int v_rd_off(int d0, int ks, int half) { return d0 * 512 + ks * 4096 + half * 2048; }
template <int OFF> __device__ __forceinline__ s16x4 tr_read(int vb) {
  s16x4 r; asm volatile("ds_read_b64_tr_b16 %0, %1 offset:%2" : "=&v"(r) : "v"(vb), "i"(OFF) : "memory"); return r;
}
template <int D0> __device__ __forceinline__ void pv_one(f32x16& od, int vb, bf16x8 pa0, bf16x8 pa1, bf16x8 pa2, bf16x8 pa3) {
  const s16x4 l0 = tr_read<v_rd_off(D0, 0, 0)>(vb), h0 = tr_read<v_rd_off(D0, 0, 1)>(vb), l1 = tr_read<v_rd_off(D0, 1, 0)>(vb), h1 = tr_read<v_rd_off(D0, 1, 1)>(vb);
  const s16x4 l2 = tr_read<v_rd_off(D0, 2, 0)>(vb), h2 = tr_read<v_rd_off(D0, 2, 1)>(vb), l3 = tr_read<v_rd_off(D0, 3, 0)>(vb), h3 = tr_read<v_rd_off(D0, 3, 1)>(vb);
  asm volatile("s_waitcnt lgkmcnt(0)" ::: "memory"); SBAR();
#define PK(L, H) (bf16x8){L[0], L[1], L[2], L[3], H[0], H[1], H[2], H[3]}
  od = __builtin_amdgcn_mfma_f32_32x32x16_bf16(pa0, PK(l0, h0), od, 0, 0, 0);
  od = __builtin_amdgcn_mfma_f32_32x32x16_bf16(pa1, PK(l1, h1), od, 0, 0, 0);
  od = __builtin_amdgcn_mfma_f32_32x32x16_bf16(pa2, PK(l2, h2), od, 0, 0, 0);
  od = __builtin_amdgcn_mfma_f32_32x32x16_bf16(pa3, PK(l3, h3), od, 0, 0, 0);
#undef PK
}
__device__ __forceinline__ void pv_d0(f32x16* o, int vb, bf16x8 pa0, bf16x8 pa1, bf16x8 pa2, bf16x8 pa3) {
  pv_one<0>(o[0], vb, pa0, pa1, pa2, pa3); pv_one<1>(o[1], vb, pa0, pa1, pa2, pa3); pv_one<2>(o[2], vb, pa0, pa1, pa2, pa3); pv_one<3>(o[3], vb, pa0, pa1, pa2, pa3);
}

__device__ __forceinline__ void attn_dense_body(const bf16* __restrict__ Qb, const bf16* __restrict__ Kh, const bf16* __restrict__ Vh,
                                                bf16* __restrict__ Ob, int seq, char* lds, const int tid, const float mnC) {
  const int wid = tid >> 6, lane = tid & 63, r32 = lane & 31, hi = lane >> 5;
  bf16* V_lds = (bf16*)lds; bf16* K_lds = (bf16*)(lds + 2 * SHM_V);
  float* ws = (float*)(lds + 2 * SHM_V + 2 * SHM_K) + wid * 64; float* li_l = ws;
  float l_reg = 0; f32x16 o[4] = {}; bf16x8 qr[8];
  const bf16* Qw = Qb + (long)(wid * QBLK + r32) * LDQ + hi * 8;
#pragma unroll
  for (int d0 = 0; d0 < 8; ++d0) qr[d0] = ld8(Qw + d0 * 16);
  const int sr = tid >> 4, sc = (tid & 15) * 8, vst0 = v_st(sr, sc), vst1 = v_st(32 + sr, sc);
  const int vb0 = (int)(uintptr_t)V_lds + v_rd_base(lane);
  bf16x8 s0_vs0, s0_vs1, s0_ks0, s0_ks1;
#define SLOAD0(k0) do { s0_vs0 = ld8(&Vh[(long)((k0) + sr) * LDK + sc]); s0_vs1 = ld8(&Vh[(long)((k0) + 32 + sr) * LDK + sc]); \
    s0_ks0 = ld8(&Kh[(long)((k0) + sr) * LDK + sc]); s0_ks1 = ld8(&Kh[(long)((k0) + 32 + sr) * LDK + sc]); } while (0)
#define SWRITE0(b) do { *(bf16x8*)((char*)V_lds + (b) * SHM_V + vst0) = s0_vs0; *(bf16x8*)((char*)V_lds + (b) * SHM_V + vst1) = s0_vs1; const int kc = sc * 2; \
    *(bf16x8*)((char*)K_lds + (b) * SHM_K + KSWZ(sr, kc)) = s0_ks0; *(bf16x8*)((char*)K_lds + (b) * SHM_K + KSWZ(32 + sr, kc)) = s0_ks1; } while (0)
#define SWAIT() asm volatile("s_waitcnt vmcnt(0)" ::: "memory")
  f32x16 pA0, pA1, pB0, pB1; bf16x8 pa0, pa1, pa2, pa3; const int NT = seq / KVBLK;
  SLOAD0(0);
  bf16x8 t1_vs0 = ld8(&Vh[(long)(KVBLK + sr) * LDK + sc]), t1_vs1 = ld8(&Vh[(long)(KVBLK + 32 + sr) * LDK + sc]);
  bf16x8 t1_ks0 = ld8(&Kh[(long)(KVBLK + sr) * LDK + sc]), t1_ks1 = ld8(&Kh[(long)(KVBLK + 32 + sr) * LDK + sc]);
  asm volatile("s_waitcnt vmcnt(4)" ::: "memory"); SWRITE0(0); __syncthreads();
  qkt(pA0, pA1, K_lds, qr, r32, hi); partialSM(pA0, pA1, mnC);
  s0_vs0 = t1_vs0; s0_vs1 = t1_vs1; s0_ks0 = t1_ks0; s0_ks1 = t1_ks1;
  SWAIT(); SWRITE0(1); __syncthreads();
  if (__builtin_amdgcn_readfirstlane(wid) >= 4) __builtin_amdgcn_s_setprio(1);
  for (int j = 1; j + 1 < NT; j += 2) {
    SBAR(); qkt(pB0, pB1, (bf16*)((char*)K_lds + SHM_K), qr, r32, hi);
    finishSM(pA0, pA1, l_reg, pa0, pa1, pa2, pa3); SBAR();
    SLOAD0((j + 1) * KVBLK); SBAR();
    pv_d0(o, vb0, pa0, pa1, pa2, pa3); partialSM(pB0, pB1, mnC);
    __syncthreads(); SWAIT(); SWRITE0(0);
    SBAR(); __syncthreads();
    SBAR(); qkt(pA0, pA1, K_lds, qr, r32, hi);
    finishSM(pB0, pB1, l_reg, pa0, pa1, pa2, pa3); SBAR();
    SLOAD0((j + 2) * KVBLK); SBAR();
    pv_d0(o, vb0 + (int)SHM_V, pa0, pa1, pa2, pa3); partialSM(pA0, pA1, mnC);
    __syncthreads(); SWAIT(); SWRITE0(1);
    SBAR(); __syncthreads();
  }
  SBAR(); qkt(pB0, pB1, (bf16*)((char*)K_lds + SHM_K), qr, r32, hi);
  finishSM(pA0, pA1, l_reg, pa0, pa1, pa2, pa3); SBAR();
  pv_d0(o, vb0, pa0, pa1, pa2, pa3); partialSM(pB0, pB1, mnC);
  __syncthreads();
  finishSM(pB0, pB1, l_reg, pa0, pa1, pa2, pa3); SBAR();
  pv_d0(o, vb0 + (int)SHM_V, pa0, pa1, pa2, pa3);
  { auto rr = __builtin_amdgcn_permlane32_swap(__float_as_uint(l_reg), __float_as_uint(l_reg), false, false);
    l_reg = __uint_as_float(rr[0]) + __uint_as_float(rr[1]); }
  __builtin_amdgcn_s_setprio(0);
  if (hi == 0) li_l[r32] = l_reg; asm volatile("s_waitcnt lgkmcnt(0)" ::: "memory");
  float rli[16];
#pragma unroll
  for (int r = 0; r < 16; ++r) rli[r] = __builtin_amdgcn_rcpf(li_l[crow(r, hi)]);
  bf16* Ow = Ob + (long)(wid * QBLK) * LDO;
#pragma unroll
  for (int r = 0; r < 16; ++r) { const int orow = crow(r, hi);
#pragma unroll
    for (int d0 = 0; d0 < 4; ++d0) Ow[(long)orow * LDO + d0 * 32 + r32] = __float2bfloat16(o[d0][r] * rli[r]); }
  __syncthreads();
#undef SLOAD0
#undef SWRITE0
#undef SWAIT
}
}

#define LAS __attribute__((address_space(3)))
typedef unsigned short bf16;
typedef float f32x4 __attribute__((ext_vector_type(4)));
typedef float f32x2 __attribute__((ext_vector_type(2)));
typedef unsigned v4u __attribute__((ext_vector_type(4)));
typedef unsigned v2u __attribute__((ext_vector_type(2)));
typedef short s16x8 __attribute__((ext_vector_type(8)));

constexpr int NWAVES = 8;
constexpr int LDS_BYTES = 147456;
constexpr size_t MiB = 1u << 20;
constexpr size_t WS_MOD  = 0;
constexpr size_t WS_W1   = 1 * MiB;
constexpr size_t WS_W2   = WS_W1 + 32 * MiB;
constexpr size_t WS_WIN  = WS_W2 + 32 * MiB;
constexpr size_t WS_WQKV = WS_WIN + 8 * MiB;
constexpr size_t WS_WO   = WS_WQKV + 4 * MiB;
constexpr size_t WS_WOUT = WS_WO + 2 * MiB;
constexpr size_t WS_WP   = WS_WOUT + 4 * MiB;
constexpr size_t WS_WS   = WS_WP + 1 * MiB;
constexpr size_t WS_HCTX = WS_WS + 1 * MiB;
constexpr size_t WS_A    = WS_HCTX + 2 * MiB;
constexpr size_t WS_F    = WS_A + 33 * MiB;
constexpr size_t WS_G    = WS_F + 132 * MiB;
constexpr size_t WS_ST   = WS_G + 64 * MiB;
constexpr size_t WS_SSQ  = WS_ST + 4 * MiB;
constexpr size_t WS_H16  = WS_SSQ + 2 * MiB;
constexpr size_t WS_END  = WS_H16 + 33 * MiB;
constexpr size_t WS_BIAS = 512 * 1024;
constexpr size_t WS_BAR  = 896 * 1024;
constexpr int LDS_BARST = LDS_BYTES - 64;
constexpr size_t F_Q = 66 * MiB, F_K = F_Q + 32 * MiB, F_V = F_K + 17 * MiB;
static_assert(F_V + 17 * MiB <= 132 * MiB, "Q|K|V inside F");

struct Args {
    const float *x, *c, *ctx, *c_ctx, *ada_w, *ada_b, *norm_g, *mlp_w1, *mlp_w2, *pool_w, *pool_scale, *attn_w_qkv, *attn_w_o, *attn_q_g, *attn_k_g,
                *gm_w_in, *gm_ln_g, *gm_ln_b, *gm_ws, *gm_bs, *gm_w_out, *final_g;
    float* out; unsigned char* ws; int ph_lo, ph_hi;
};

__device__ __forceinline__ unsigned f2bf(float f) { unsigned u = __builtin_bit_cast(unsigned, f); return (u + 0x7fffu + ((u >> 16) & 1u)) >> 16; }
__device__ __forceinline__ unsigned pk2(float lo, float hi) { return pg8::cvt_pk_bf16(lo, hi); }
__device__ __forceinline__ float bf_lo(unsigned w) { return __uint_as_float(w << 16); }
__device__ __forceinline__ float bf_hi(unsigned w) { return __uint_as_float(w & 0xffff0000u); }
__device__ __forceinline__ float wave_sum(float v) {
#pragma unroll
    for (int o = 1; o < 64; o <<= 1) v += __shfl_xor(v, o);
    return v;
}
__device__ __forceinline__ const float* rowp(const float* lat, const float* ctx, int row) { return row < MLAT ? lat + (size_t)row * DM : ctx + (size_t)(row - MLAT) * DM; }
__device__ __forceinline__ int bidx(int row) { return row >= MLAT ? 2 : (row >> 13); }


#define XB_TMO      128
#define XB_XCNT(j)  (256  + 64 * (j))
#define XB_XSUB(j)  (1280 + 64 * (j))
#define XB_XGEN(j)  (2304 + 64 * (j))
#define XB_TOP      3328
#define XB_TOPGEN   3392
#define XCD_BAR_WORDS 3456
#define XB_SPIN_CAP (1u << 18)
__device__ __forceinline__ unsigned xb_ld(unsigned* p)              { return __hip_atomic_load(p, __ATOMIC_RELAXED, __HIP_MEMORY_SCOPE_AGENT); }
__device__ __forceinline__ unsigned xb_add(unsigned* p, unsigned v) { return __hip_atomic_fetch_add(p, v, __ATOMIC_RELAXED, __HIP_MEMORY_SCOPE_AGENT); }
__device__ __forceinline__ unsigned xb_xcc_id() { return (unsigned)__builtin_amdgcn_s_getreg((3 << 11) | 20) & 0xFu; }
#define XB_SPIN(cond, bar) do { unsigned _sp = 0; while (cond) { __builtin_amdgcn_s_sleep(1); \
    if ((++_sp & 255u) == 0u) { if (xb_ld(&(bar)[XB_TMO])) break; if (_sp > XB_SPIN_CAP) { atomicAdd(&(bar)[XB_TMO], 1u); break; } } } } while (0)
struct XcdBarrier { unsigned* bar; unsigned x; volatile LAS unsigned* st; };
__device__ __forceinline__ XcdBarrier xcd_barrier_post(unsigned* bar, volatile LAS unsigned* st, int tid) {
    XcdBarrier b; b.bar = bar; b.x = xb_xcc_id(); b.st = st;
    if (tid == 0) (void)xb_add(&bar[XB_XCNT(b.x)], 1u);
    return b;
}
__device__ __forceinline__ void xcd_barrier_complete(unsigned* bar, unsigned x, unsigned& nloc, unsigned& nx) {
    const unsigned G = gridDim.x * gridDim.y * gridDim.z;
    unsigned sum, cnt, mine, sp = 0u;
    for (;;) {
        sum = 0u; cnt = 0u; mine = 0u;
#pragma unroll
        for (unsigned j = 0; j < 16; ++j) { const unsigned c = xb_ld(&bar[XB_XCNT(j)]); sum += c; cnt += (c > 0u) ? 1u : 0u; mine = (j == x) ? c : mine; }
        if (sum == G) break;
        __builtin_amdgcn_s_sleep(1);
        if ((++sp & 255u) == 0u) { if (xb_ld(&bar[XB_TMO])) break; if (sp > XB_SPIN_CAP) { atomicAdd(&bar[XB_TMO], 1u); break; } }
    }
    nloc = mine > 0u ? mine : 1u; nx = cnt > 0u ? cnt : 1u;
}
__device__ __forceinline__ void xcd_barrier(const XcdBarrier& b, int tid) {
    asm volatile("s_waitcnt vmcnt(0)" ::: "memory");
    __syncthreads();
    if (tid == 0) {
        unsigned* bar = b.bar;
        __builtin_amdgcn_s_waitcnt(0);
        unsigned nloc = b.st[0], nx = b.st[1];
        if (nloc == 0u) { xcd_barrier_complete(bar, b.x, nloc, nx); b.st[0] = nloc; b.st[1] = nx; }
        const unsigned old = xb_add(&bar[XB_XSUB(b.x)], 1u);
        const unsigned gen = old / nloc;
        if (old + 1u == (gen + 1u) * nloc) {
            __builtin_amdgcn_fence(__ATOMIC_RELEASE, "agent");
            asm volatile("s_waitcnt vmcnt(0)" ::: "memory");
            const unsigned og = xb_add(&bar[XB_TOP], 1u);
            const unsigned tg = og / nx;
            if (og + 1u == (tg + 1u) * nx) xb_add(&bar[XB_TOPGEN], 1u);
            else XB_SPIN(xb_ld(&bar[XB_TOPGEN]) == tg, bar);
            __builtin_amdgcn_fence(__ATOMIC_ACQUIRE, "agent");
            xb_add(&bar[XB_XGEN(b.x)], 1u);
            asm volatile("s_waitcnt vmcnt(0)" ::: "memory");
        } else {
            XB_SPIN(xb_ld(&bar[XB_XGEN(b.x)]) == gen, bar);
            __builtin_amdgcn_fence(__ATOMIC_ACQUIRE, "agent");
            asm volatile("s_waitcnt vmcnt(0)" ::: "memory");
        }
    }
    __syncthreads();
}

struct TrD { const float* W; bf16* WT; int K, N, item, perm; };
__device__ __forceinline__ void tr_load(const TrD& d, int lane, f32x4 (&v)[16]) {
    const int nblk = d.N / 64, kb = d.item / nblk, nb = d.item % nblk, k0 = 64 * kb, n0 = 64 * nb, lr = lane >> 4, lc = (lane & 15) * 4;
    const float* src = d.W + (size_t)(k0 + lr) * d.N + n0 + lc;
#pragma unroll
    for (int i = 0; i < 16; ++i) v[i] = __builtin_nontemporal_load((const f32x4*)(src + (size_t)(4 * i) * d.N));
}
__device__ __forceinline__ void tr_lds_write(LAS float* scr, int lane, const f32x4 (&v)[16]) {
    const int lr = lane >> 4, lc = (lane & 15) * 4;
#pragma unroll
    for (int i = 0; i < 16; ++i) { const int kk = 4 * i + lr; scr[kk * 65 + lc + 0] = v[i][0]; scr[kk * 65 + lc + 1] = v[i][1]; scr[kk * 65 + lc + 2] = v[i][2]; scr[kk * 65 + lc + 3] = v[i][3]; }
    asm volatile("s_waitcnt lgkmcnt(0)" ::: "memory");
}
__device__ __forceinline__ void tr_store(const TrD& d, LAS float* scr, int lane) {
    const int nblk = d.N / 64, kb = d.item / nblk, nb = d.item % nblk, k0 = 64 * kb, n0 = 64 * nb, c = lane & 7;
#pragma unroll
    for (int j = 0; j < 8; ++j) { const int n = (lane >> 3) + 8 * j; const LAS float* s = scr + (8 * c) * 65 + n;
        v4u o; o.x = pk2(s[0 * 65], s[1 * 65]); o.y = pk2(s[2 * 65], s[3 * 65]); o.z = pk2(s[4 * 65], s[5 * 65]); o.w = pk2(s[6 * 65], s[7 * 65]);
        int dn = n0 + n; if (d.perm && dn < 1536) { const int f = dn & 127; dn = (dn & ~127) | ((f >> 6) * 64 + 2 * (f & 31) + ((f >> 5) & 1)); }
        __builtin_nontemporal_store(o, (v4u*)(d.WT + (size_t)dn * d.K + k0 + 8 * c)); }
    asm volatile("s_waitcnt lgkmcnt(0)" ::: "memory");
}
__device__ __forceinline__ void norm_phase(const float* hl, const float* hc, int nrows, const float* ng, const float* modl  , int which_shift, bf16* out, int gw, int NGW, int lane) {
    f32x4 g4[4];
#pragma unroll
    for (int j = 0; j < 4; ++j) g4[j] = *(const f32x4*)(ng + 4 * lane + 256 * j);
    for (int row = gw; row < nrows; row += NGW) {
        const f32x4* xr = (const f32x4*)rowp(hl, hc, row) + lane;
        const float* mp = modl + bidx(row) * 6144 + which_shift * 1024;
        f32x4 v[4]; float ss = 0.f;
#pragma unroll
        for (int j = 0; j < 4; ++j) { v[j] = xr[64 * j]; ss += (v[j][0] * v[j][0] + v[j][1] * v[j][1]) + (v[j][2] * v[j][2] + v[j][3] * v[j][3]); }
        const float rstd = rsqrtf(wave_sum(ss) * (1.f / DM) + EPS);
        unsigned long long* o8 = (unsigned long long*)(out + (size_t)row * DM) + lane;
#pragma unroll
        for (int j = 0; j < 4; ++j) { const f32x4 sh = *(const f32x4*)(mp + 4 * lane + 256 * j), sc = *(const f32x4*)(mp + 1024 + 4 * lane + 256 * j);
            const f32x4 y = (v[j] * rstd * g4[j]) * (sc + 1.0f) + sh;
            o8[64 * j] = (unsigned long long)pk2(y[0], y[1]) | ((unsigned long long)pk2(y[2], y[3]) << 32); }
    }
}

__global__ void __launch_bounds__(NWAVES * 64, 2) fwd_kernel(Args args) {
    extern __shared__ __attribute__((aligned(16))) unsigned char lds[];
    cg::grid_group grid = cg::this_grid();
    LAS unsigned char* L = (LAS unsigned char*)lds;
    const int tid0 = threadIdx.x;
    const int G0 = gridDim.x, bx0 = blockIdx.x;
    typedef const __attribute__((address_space(4))) Args* ArgP;
    const ArgP argp = (ArgP)__builtin_amdgcn_kernarg_segment_ptr();
    ArgP A_ = argp;
#define WSP(T, off) ((T*)(A_->ws + (off)))
#define MOD   WSP(float, WS_MOD)
#define W1T   WSP(bf16, WS_W1)
#define W2T   WSP(bf16, WS_W2)
#define WINT  WSP(bf16, WS_WIN)
#define WQKVT WSP(bf16, WS_WQKV)
#define WOT   WSP(bf16, WS_WO)
#define WOUTT WSP(bf16, WS_WOUT)
#define WPT   WSP(bf16, WS_WP)
#define WSB   WSP(bf16, WS_WS)
#define CACC  WSP(float, WS_G)
#define H16   WSP(bf16, WS_H16)
#define AB    WSP(bf16, WS_A)
#define FB    WSP(bf16, WS_F)
#define GB    WSP(bf16, WS_G)
#define ST    WSP(float, WS_ST)
#define QB    WSP(bf16, WS_F + F_Q)
#define KB    WSP(bf16, WS_F + F_K)
#define VB    WSP(bf16, WS_F + F_V)
#define BI_W1  WSP(float, WS_BIAS)
#define BI_QKV WSP(float, WS_BIAS + 4 * 3 * 4096 * 4)
#define BI_WIN WSP(float, WS_BIAS + 4 * 3 * 4096 * 4 + 3 * 2048 * 4)
#define SSQ    WSP(float, WS_SSQ)
    const int lo = args.ph_lo, hi = args.ph_hi;
    int ph = 0;
    if (tid0 < 2) ((volatile LAS unsigned*)(L + LDS_BARST))[tid0] = 0u;
    __syncthreads();
    XcdBarrier xbar = xcd_barrier_post((unsigned*)(A_->ws + WS_BAR), (volatile LAS unsigned*)(L + LDS_BARST), tid0);
#define PHASE_BEGIN_C(cls) if (lo <= ph && ph < hi) { for (int rep_ = 0; rep_ <= ((PROBE_MASK >> (cls)) & 1); ++rep_) { int tid = tid0; asm volatile("" : "+v"(tid)); const int lane = tid & 63, wave = __builtin_amdgcn_readfirstlane(tid >> 6); int bx = bx0, G = G0; asm volatile("" : "+s"(bx), "+s"(G)); const int gw = bx * NWAVES + wave, NGW = G * NWAVES; (void)lane; (void)gw; (void)NGW; ArgP A_ = argp; asm volatile("" : "+s"(A_));
#define PHASE_BEGIN PHASE_BEGIN_C(31)
#define PHASE_END   } if (ph + 1 < hi) { if (lo < 0) grid.sync(); int tb_ = tid0; asm volatile("" : "+v"(tb_)); xcd_barrier(xbar, tb_); if ((PROBE_MASK >> 8) & 1) xcd_barrier(xbar, tb_); } } ++ph;

    constexpr int I_W = 1024, I_QKV = 512, I_O = 256, I_OUT = 512, I_P = 16;
#define TR_DECODE(r_, D) do { int r = (r_); \
            if (r < 4 * I_W) { const int l = r / I_W; D = TrD{A_->mlp_w1 + (size_t)l * DM * DFF, W1T + (size_t)l * DM * DFF, DM, DFF, r % I_W, 0}; break; } r -= 4 * I_W; \
            if (r < 4 * I_W) { const int l = r / I_W; D = TrD{A_->mlp_w2 + (size_t)l * DM * DFF, W2T + (size_t)l * DM * DFF, DFF, DM, r % I_W, 0}; break; } r -= 4 * I_W; \
            if (r < I_W) { D = TrD{A_->gm_w_in, WINT, DM, 4096, r, 0}; break; } r -= I_W; \
            if (r < I_QKV) { D = TrD{A_->attn_w_qkv, WQKVT, DM, 2048, r, 1}; break; } r -= I_QKV; \
            if (r < I_O) { D = TrD{A_->attn_w_o, WOT, DM, DM, r, 0}; break; } r -= I_O; \
            if (r < I_OUT) { D = TrD{A_->gm_w_out, WOUTT, 2048, DM, r, 0}; break; } r -= I_OUT; \
            { const int m = r / I_P; D = TrD{A_->pool_w + (size_t)m * 65536, WPT + (size_t)m * 65536, 256, 256, r % I_P, 0}; } } while (0)
#define TR_SETMAP(SET, j) ((SET) == 0 ? ((j) < 1024 ? (j) : 10496 + ((j) - 1024)) : \
                           (SET) == 1 ? ((j) < 512 ? 9216 + (j) : 9728 + ((j) - 512)) : \
                           (SET) == 2 ? ((j) < 1024 ? 1024 + (j) : ((j) < 2048 ? 5120 + ((j) - 1024) : ((j) < 3072 ? 8192 + ((j) - 2048) : 4096 + ((j) - 3072)))) : \
                           (SET) == 3 ? ((j) < 512 ? 9984 + (j) : ((j) < 1536 ? 2048 + ((j) - 512) : ((j) < 2560 ? 6144 + ((j) - 1536) : 3072 + ((j) - 2560)))) : \
                                        7168 + (j))
#define TR_RUN(SET, NSET, IW, NW) do { TrD d, dn; f32x4 v[16]; const int iw_ = (IW), nw_ = (NW); \
        { const int j0_ = iw_ < (NSET) ? iw_ : 0; TR_DECODE(TR_SETMAP(SET, j0_), d); } tr_load(d, lane, v); \
        for (int j = iw_; j < (NSET); j += nw_) { tr_lds_write(scr, lane, v); \
            { const int jn_ = j + nw_ < (NSET) ? j + nw_ : j; TR_DECODE(TR_SETMAP(SET, jn_), dn); } tr_load(dn, lane, v); \
            tr_store(d, scr, lane); d = dn; } } while (0)
#define BIAS_RUN(LO, HI, IW, NW) do { const int iw_ = (IW), nw_ = (NW), ntrip = ((HI) - (LO) + nw_ - 1) / nw_; \
        for (int i0 = 0; i0 < ntrip; i0 += 4) { float sb[4][3]; float* outp[4]; int nbv[4]; bool okv[4]; \
            _Pragma("unroll") for (int k = 0; k < 4; ++k) { int r = (LO) + iw_ + (i0 + k) * nw_; const bool ok = (i0 + k) < ntrip && r < (HI); r = ok ? r : (LO); okv[k] = ok; \
                const int mid = r < 16384 ? (r >> 12) : (r < 18432 ? 4 : 5), n = r < 16384 ? (r & 4095) : (r < 18432 ? r - 16384 : r - 18432); \
                const size_t woff = mid < 4 ? WS_W1 + ((size_t)mid * 4096 + n) * 2048 : (mid == 4 ? WS_WQKV + (size_t)n * 2048 : WS_WIN + (size_t)n * 2048); \
                const int ml = mid < 4 ? mid : mid - 3, which = mid < 4 ? 3 : 0; nbv[k] = mid == 4 ? 2048 : 4096; \
                const size_t ooff = mid < 4 ? (size_t)mid * 3 * 4096 : (mid == 4 ? (size_t)4 * 3 * 4096 : (size_t)4 * 3 * 4096 + 3 * 2048); \
                const bf16* wrow = (const bf16*)(A_->ws + woff); const float* shp = MOD + (size_t)ml * 3 * 6144 + which * 1024; outp[k] = BI_W1 + ooff + n; \
                const v4u w0 = *(const v4u*)(wrow + 16 * lane), w1 = *(const v4u*)(wrow + 16 * lane + 8); \
                const f32x4 wf0 = {bf_lo(w0.x), bf_hi(w0.x), bf_lo(w0.y), bf_hi(w0.y)}, wf1 = {bf_lo(w0.z), bf_hi(w0.z), bf_lo(w0.w), bf_hi(w0.w)}; \
                const f32x4 wf2 = {bf_lo(w1.x), bf_hi(w1.x), bf_lo(w1.y), bf_hi(w1.y)}, wf3 = {bf_lo(w1.z), bf_hi(w1.z), bf_lo(w1.w), bf_hi(w1.w)}; \
                _Pragma("unroll") for (int b = 0; b < 3; ++b) { const f32x4* sp = (const f32x4*)(shp + b * 6144 + 16 * lane); \
                    const f32x4 a4 = (wf0 * sp[0] + wf1 * sp[1]) + (wf2 * sp[2] + wf3 * sp[3]); sb[k][b] = (a4[0] + a4[1]) + (a4[2] + a4[3]); } } \
            _Pragma("unroll") for (int o = 1; o < 64; o <<= 1) _Pragma("unroll") for (int k = 0; k < 4; ++k) { sb[k][0] += __shfl_xor(sb[k][0], o); sb[k][1] += __shfl_xor(sb[k][1], o); sb[k][2] += __shfl_xor(sb[k][2], o); } \
            _Pragma("unroll") for (int k = 0; k < 4; ++k) if (okv[k] && lane == 0) { outp[k][0] = sb[k][0]; outp[k][nbv[k]] = sb[k][1]; outp[k][2 * (size_t)nbv[k]] = sb[k][2]; } } } while (0)
#define TAIL_FIRST(NWG) ((NWG) % G)

    PHASE_BEGIN_C(0)
    {
        LAS float* sl = (LAS float*)L;
        LAS float* red = (LAS float*)(L + 12288);
        if (bx < 192) {
            for (int i = tid; i < 3 * 1024; i += 512) { const float cv = i < 2048 ? A_->c[i] : A_->c_ctx[i - 2048]; sl[i] = cv / (1.0f + __expf(-cv)); }
            __syncthreads();
            for (int it = bx; it < 192; it += G) {
                const int layer = it / 48, n0 = (it % 48) * 128, half = lane >> 5, cq = lane & 31;
                const float* W = A_->ada_w + (size_t)layer * 1024 * 6144 + n0 + 4 * cq;
                f32x4 a0 = {0.f, 0.f, 0.f, 0.f}, a1 = a0, a2 = a0;
#pragma unroll 16
                for (int i = 0; i < 64; ++i) { const int k = wave * 128 + 2 * i + half; const f32x4 w = __builtin_nontemporal_load((const f32x4*)(W + (size_t)k * 6144));
                    a0 += w * sl[k]; a1 += w * sl[1024 + k]; a2 += w * sl[2048 + k]; }
                const int slot = wave * 2 + half;
#pragma unroll
                for (int e = 0; e < 4; ++e) { red[(slot * 3 + 0) * 128 + 4 * cq + e] = a0[e]; red[(slot * 3 + 1) * 128 + 4 * cq + e] = a1[e]; red[(slot * 3 + 2) * 128 + 4 * cq + e] = a2[e]; }
                __syncthreads();
                if (tid < 384) { const int b = tid >> 7, col = tid & 127; float s = 0.f;
#pragma unroll
                    for (int k = 0; k < 16; ++k) s += red[(k * 3 + b) * 128 + col];
                    MOD[(size_t)(layer * 3 + b) * 6144 + n0 + col] = s + A_->ada_b[layer * 6144 + n0 + col]; }
                __syncthreads();
            }
        }
        __syncthreads();
        {
          const bool split_ = G > 192; const int iw0_ = split_ ? (bx - 192) * NWAVES + wave : gw, nw0_ = split_ ? (G - 192) * NWAVES : NGW;
          if (!split_ || bx >= 192) { LAS float* scr = (LAS float*)(L + wave * 16640); TR_RUN(0, 1152, iw0_, nw0_); } }
        for (int row = gw; row < MALL; row += 2 * NGW) { const int rowb = row + NGW < MALL ? row + NGW : row;
            const f32x4* xa = (const f32x4*)rowp(A_->x, A_->ctx, row) + lane; const f32x4* xb = (const f32x4*)rowp(A_->x, A_->ctx, rowb) + lane; f32x4 va[4], vb[4];
#pragma unroll
            for (int j = 0; j < 4; ++j) { va[j] = xa[64 * j]; vb[j] = xb[64 * j]; }
            float sa = 0.f, sb = 0.f;
#pragma unroll
            for (int j = 0; j < 4; ++j) { sa += (va[j][0] * va[j][0] + va[j][1] * va[j][1]) + (va[j][2] * va[j][2] + va[j][3] * va[j][3]); sb += (vb[j][0] * vb[j][0] + vb[j][1] * vb[j][1]) + (vb[j][2] * vb[j][2] + vb[j][3] * vb[j][3]); }
#pragma unroll
            for (int o = 1; o < 64; o <<= 1) { sa += __shfl_xor(sa, o); sb += __shfl_xor(sb, o); }
            if (lane < 16) { SSQ[(size_t)row * 16 + lane] = lane == 0 ? sa : 0.f; SSQ[(size_t)rowb * 16 + lane] = lane == 0 ? sb : 0.f; } }
        for (int i = bx * 512 + tid; i < 8 * 128 * 128 / 4; i += G * 512) { const f32x4 v = *(const f32x4*)(A_->gm_ws + 4 * (size_t)i);
            *(v2u*)(WSB + 4 * (size_t)i) = (v2u){pk2(v[0], v[1]), pk2(v[2], v[3])}; }
        __syncthreads();
    }
    PHASE_END

#pragma unroll 1
    for (int layer = 0; layer < DEPTH; ++layer) {
#define kind   (layer % 3)
#define jl     (layer / 3)
#define modl   (MOD + (size_t)layer * 3 * 6144)
#define ng0    (A_->norm_g + (size_t)layer * 2 * DM)
#define ng1    (ng0 + DM)
#define nrows  (layer == 0 ? MALL : MLAT)
#define src_l  (A_->x)
#define src_c  (A_->ctx)
#define next_hb ((layer + 1 < DEPTH) && ((layer + 1) % 3 != 0))

        if (kind == 0) {
            PHASE_BEGIN_C(layer == 0 ? 1 : 13)
            {
                LAS float* rs = (LAS float*)L;
                LAS f32x4* tile = (LAS f32x4*)(L + 512);
                const int nitems = (nrows / 64) * 4;
                f32x4 pv[10]; float rreg;
#define PL_DECODE(it_, g_, t0_, ss_, Ls_, b_) const int g_ = (it_) & 3, t0_ = ((it_) >> 2) * 64; int ss_, Ls_, b_; \
        if (t0_ < MLAT) { ss_ = t0_ & ~(SEQ - 1); Ls_ = SEQ; b_ = t0_ >> 13; } else { ss_ = MLAT + ((t0_ - MLAT) & ~(CTXL - 1)); Ls_ = CTXL; b_ = 2; }
#define PL_PREFETCH(it_) do { PL_DECODE(it_, gp_, t0p_, ssp_, Lsp_, bp_) (void)bp_; const int T0p_ = t0p_ - ssp_; \
        _Pragma("unroll") for (int k = 0; k < 10; ++k) { const int i = tid + 512 * k, pos = T0p_ - 8 + (i >> 6); int pc = pos < 0 ? 0 : (pos >= Lsp_ ? Lsp_ - 1 : pos); \
            f32x4 v; if (layer == 0) v = *(const f32x4*)(rowp(src_l, src_c, ssp_ + pc) + 256 * gp_ + 4 * (i & 63)); \
            else { const v2u r_ = *(const v2u*)(H16 + (size_t)(ssp_ + pc) * DM + 256 * gp_ + 4 * (i & 63)); v = (f32x4){bf_lo(r_.x), bf_hi(r_.x), bf_lo(r_.y), bf_hi(r_.y)}; } \
            if (pc != pos) v = (f32x4){0.f, 0.f, 0.f, 0.f}; pv[k] = v; } \
        { const int pos = T0p_ - 8 + (tid < 80 ? tid : 0); const int pc = pos < 0 ? 0 : (pos >= Lsp_ ? Lsp_ - 1 : pos); \
          const f32x4* sp = (const f32x4*)(SSQ + (size_t)(ssp_ + pc) * 16); const f32x4 t4 = (sp[0] + sp[1]) + (sp[2] + sp[3]); \
          rreg = pc == pos ? rsqrtf(((t4[0] + t4[1]) + (t4[2] + t4[3])) * (1.f / DM) + EPS) : 0.f; } } while (0)
                { const int it0_ = bx < nitems ? bx : 0; PL_PREFETCH(it0_); }
                for (int it = bx; it < nitems; it += G) {
                    PL_DECODE(it, g, t0, seq_start, Ls, b) const int hw = 1 << g, T0 = t0 - seq_start;
                    if (tid < 80) rs[tid] = rreg;
#pragma unroll
                    for (int k = 0; k < 10; ++k) tile[tid + 512 * k] = pv[k];
                    __syncthreads();
                    { const int itn_ = it + G < nitems ? it + G : it; PL_PREFETCH(itn_); }
                    { const int q = tid & 63, rg = tid >> 6, lb = rg * 8 + 8; const float* mp = modl + b * 6144;
                      const f32x4 cA = *(const f32x4*)(ng0 + 256 * g + 4 * q) * (*(const f32x4*)(mp + 1024 + 256 * g + 4 * q) + 1.0f);
#define TV(i_) (tile[(i_) * 64 + q] * rs[(i_)])
                      f32x4 S = TV(lb - hw);
                      if (g == 0) { S += TV(lb); }
                      else if (g == 1) {
#pragma unroll
                          for (int i = 1; i < 4; ++i) S += TV(lb - 2 + i); }
                      else if (g == 2) {
#pragma unroll
                          for (int i = 1; i < 8; ++i) S += TV(lb - 4 + i); }
                      else {
#pragma unroll
                          for (int i = 1; i < 16; ++i) S += TV(lb - 8 + i); }
#pragma unroll
                      for (int j = 0; j < 8; ++j) { const int pos = T0 + rg * 8 + j;
                          const int wlo = pos - hw < 0 ? 0 : pos - hw, whi = pos + hw > Ls ? Ls : pos + hw;
                          const f32x4 pvv = (S * (1.0f / (float)(whi - wlo)) - TV(lb + j)) * cA;
                          *(v2u*)(AB + (size_t)(seq_start + pos) * DM + 256 * g + 4 * q) = (v2u){pk2(pvv[0], pvv[1]), pk2(pvv[2], pvv[3])};
                          if (j < 7) S += TV(lb + j + hw) - TV(lb + j - hw); }
#undef TV
                    }
                    __syncthreads();
                }
#undef PL_PREFETCH
#undef PL_DECODE
                if (layer == 0) {
                }
            }
            PHASE_END
            PHASE_BEGIN
            {
                pg8::Gemm g{AB, WPT + (size_t)jl * 1024 * 256, nrows, DM, 256, DM, 512, 256}; pg8::StaticOrder S; S.init(nrows, DM, G, bx);
                pg8::EpiRes E{layer == 0 ? src_l : nullptr, layer == 0 ? src_c : nullptr, H16, modl + 2 * 1024, A_->pool_scale + (size_t)jl * DM, AB, ng1, modl + 4 * 1024, SSQ};
                pg8::gemm_phase<pg8::EpiRes, pg8::StaticOrder>(L, g, S, E, tid);
                if (layer == 0) { const int fi = TAIL_FIRST(nrows / 256 * 4);
                    if (bx >= fi) { LAS float* scr = (LAS float*)(L + wave * 16640); TR_RUN(1, 768, (bx - fi) * NWAVES + wave, (G - fi) * NWAVES);
                        BIAS_RUN(0, 4096, (bx - fi) * NWAVES + wave, (G - fi) * NWAVES); } }
            }
            PHASE_END
        } else if (kind == 1) {
            PHASE_BEGIN_C(6)
            {
                pg8::Gemm g{AB, WQKVT, MALL, 2048, DM, DM, 0, DM}; pg8::StaticOrder S; S.init(MALL, 2048, G, bx);
                pg8::EpiQKV E{QB, KB, VB, SSQ, BI_QKV, A_->attn_q_g + (size_t)jl * 128, A_->attn_k_g + (size_t)jl * 128, (LAS float*)(L + pg8::STAGE_BYTES)};
                pg8::gemm_phase<pg8::EpiQKV, pg8::StaticOrder>(L, g, S, E, tid);
                { const int fi = TAIL_FIRST(MALL / 256 * 8);
                  if (bx >= fi) { LAS float* scr = (LAS float*)(L + wave * 16640); TR_RUN(4, 1024, (bx - fi) * NWAVES + wave, (G - fi) * NWAVES);
                      BIAS_RUN(4096, 16384, (bx - fi) * NWAVES + wave, (G - fi) * NWAVES); BIAS_RUN(18432, 22528, (bx - fi) * NWAVES + wave, (G - fi) * NWAVES); } }
            }
            PHASE_END
            PHASE_BEGIN_C(3)
            {
                float mnC;
                { const float* qgp = A_->attn_q_g + (size_t)jl * 128; const float* kgp = A_->attn_k_g + (size_t)jl * 128;
                  float mq = fmaxf(fabsf(qgp[lane]), fabsf(qgp[64 + lane])), mk = fmaxf(fabsf(kgp[lane]), fabsf(kgp[64 + lane]));
#pragma unroll
                  for (int o = 1; o < 64; o <<= 1) { mq = fmaxf(mq, __shfl_xor(mq, o)); mk = fmaxf(mk, __shfl_xor(mk, o)); }
                  mnC = __builtin_bit_cast(float, __builtin_amdgcn_readfirstlane(__builtin_bit_cast(int, -(11.3138f * 1.01f * mq * mk + 0.05f) * 1.4426950408889634f))); }
                for (int idx = bx; idx < 512; idx += G) {
                    int tidu = tid; asm volatile("" : "+v"(tidu));
                    const int xcd = idx & 7, local = (idx >> 3) & 31, i2 = idx >> 8;
                    const int b = xcd >> 2, kvh = xcd & 3, h = kvh * 2 + i2, qblk = local;
                    const size_t qoff = ((size_t)(b * SEQ + qblk * 256)) * DM + h * 128;
                    const size_t koff = (size_t)b * SKV * 512 + kvh * 128;
                    attn::attn_dense_body((const attn::bf16*)QB + qoff, (const attn::bf16*)KB + koff, (const attn::bf16*)VB + koff, (attn::bf16*)GB + qoff, SKV, (char*)lds, tidu, mnC);
                }
            }
            PHASE_END
            PHASE_BEGIN
            {
                pg8::Gemm g{GB, WOT, MLAT, DM, DM, DM, 0, DM}; pg8::StaticOrder S; S.init(MLAT, DM, G, bx);
                pg8::EpiRes E{nullptr, nullptr, H16, modl + 2 * 1024, nullptr, AB, ng1, modl + 4 * 1024, SSQ};
                pg8::gemm_phase<pg8::EpiRes, pg8::StaticOrder>(L, g, S, E, tid);
            }
            PHASE_END
        } else {
            PHASE_BEGIN_C(6)
            {
                pg8::Gemm g{AB, WINT, MLAT, 4096, DM, DM, 0, DM}; pg8::StaticOrder S; S.init(MLAT, 4096, G, bx);
                pg8::EpiBf16<2> E{FB, 4096, ST, SSQ, BI_WIN, 4096};
                pg8::gemm_phase<pg8::EpiBf16<2>, pg8::StaticOrder>(L, g, S, E, tid);
            }
            PHASE_END
            PHASE_BEGIN_C(4)
            {
                LAS f32x2* ms = (LAS f32x2*)L;
                LAS unsigned char* vn = L + 1024;
                LAS unsigned char* wsl = L + 67584;
                const float* lng = A_->gm_ln_g + (size_t)jl * 2048; const float* lnb = A_->gm_ln_b + (size_t)jl * 2048;
                const int fr = lane & 15, fq = lane >> 4;
                const int sr = tid >> 2, spart = tid & 3, ccs = (tid & 31) * 8;
                int last_g = -1;
                float zf_ = 0.f; asm volatile("" : "+v"(zf_)); const f32x4 zero4 = {zf_, zf_, zf_, zf_};
                v4u raw[8]; f32x2 stp[8]; f32x4 ga, gb, ba, bb;
                ga = gb = ba = bb = zero4;
#define SP_PREFETCH(it_) do { const int row0_ = ((it_) >> 3) * 128, c0_ = ((it_) & 7) * 256; \
        _Pragma("unroll") for (int i = 0; i < 8; ++i) raw[i] = *(const v4u*)(FB + (size_t)(row0_ + ((tid + 512 * i) >> 5)) * 4096 + 2048 + c0_ + ccs); \
        const f32x2* sp_ = (const f32x2*)ST + (size_t)(row0_ + sr) * 32 + spart * 8; \
        _Pragma("unroll") for (int j = 0; j < 8; ++j) stp[j] = sp_[j]; } while (0)
                { const int it0_ = bx < 1024 ? bx : 0; SP_PREFETCH(it0_); }
                for (int it = bx; it < 1024; it += G) {
                    const int chunk = it >> 3, g = it & 7, row0 = chunk * 128, c0 = g * 256;
                    { float s = 0.f, q = 0.f;
#pragma unroll
                      for (int j = 0; j < 8; ++j) { s += stp[j][0]; q += stp[j][1]; }
                      s += __shfl_xor(s, 1); s += __shfl_xor(s, 2); q += __shfl_xor(q, 1); q += __shfl_xor(q, 2);
                      const float mean = s * (1.f / 2048.f), var = q * (1.f / 2048.f) - mean * mean;
                      if (spart == 0) ms[sr] = (f32x2){mean, rsqrtf(fmaxf(var, 0.f) + EPS)}; }
                    if (g != last_g) {
                        const bf16* wsg = WSB + (size_t)g * 128 * 128;
#pragma unroll
                        for (int k = 0; k < 4; ++k) { const int id = tid + 512 * k, row = id >> 4, c16 = id & 15;
                            *(LAS v4u*)(wsl + row * 272 + c16 * 16) = *(const v4u*)(wsg + (size_t)row * 128 + c16 * 8); }
                        ga = *(const f32x4*)(lng + c0 + ccs); gb = *(const f32x4*)(lng + c0 + ccs + 4); ba = *(const f32x4*)(lnb + c0 + ccs); bb = *(const f32x4*)(lnb + c0 + ccs + 4);
                        last_g = g; }
                    __syncthreads();
#pragma unroll
                    for (int i = 0; i < 8; ++i) { const int p = (tid + 512 * i) >> 5;
                        const f32x2 m2 = ms[p]; const v4u rw = raw[i];
                        const float y0 = (bf_lo(rw.x) - m2[0]) * m2[1] * ga[0] + ba[0], y1 = (bf_hi(rw.x) - m2[0]) * m2[1] * ga[1] + ba[1];
                        const float y2 = (bf_lo(rw.y) - m2[0]) * m2[1] * ga[2] + ba[2], y3 = (bf_hi(rw.y) - m2[0]) * m2[1] * ga[3] + ba[3];
                        const float y4 = (bf_lo(rw.z) - m2[0]) * m2[1] * gb[0] + bb[0], y5 = (bf_hi(rw.z) - m2[0]) * m2[1] * gb[1] + bb[1];
                        const float y6 = (bf_lo(rw.w) - m2[0]) * m2[1] * gb[2] + bb[2], y7 = (bf_hi(rw.w) - m2[0]) * m2[1] * gb[3] + bb[3];
                        LAS unsigned* dst = (LAS unsigned*)(vn + p * 516 + ccs * 2);
                        dst[0] = pk2(y0, y1); dst[1] = pk2(y2, y3); dst[2] = pk2(y4, y5); dst[3] = pk2(y6, y7); }
                    v2u uu[8][2]; float bqv[8];
                    { const float* bsg_ = A_->gm_bs + (size_t)jl * 1024 + g * 128;
#pragma unroll
                      for (int qb = 0; qb < 8; ++qb) bqv[qb] = bsg_[qb * 16 + fr]; }
#pragma unroll
                    for (int qb = 0; qb < 8; ++qb)
#pragma unroll
                        for (int cb = 0; cb < 2; ++cb) uu[qb][cb] = *(const v2u*)(FB + (size_t)(row0 + qb * 16 + fr) * 4096 + c0 + wave * 32 + cb * 16 + fq * 4);
                    __syncthreads();
                    { const int itn_ = it + G < 1024 ? it + G : it; SP_PREFETCH(itn_); }
                    f32x4 acc[2][8];
#pragma unroll
                    for (int cb = 0; cb < 2; ++cb)
#pragma unroll
                        for (int qb = 0; qb < 8; ++qb) acc[cb][qb] = zero4;
#pragma unroll 2
                    for (int ks = 0; ks < 4; ++ks) {
                        s16x8 af[2];
#pragma unroll
                        for (int cb = 0; cb < 2; ++cb) { const LAS unsigned short* vp = (const LAS unsigned short*)(vn + (ks * 32 + fq * 8) * 516 + (wave * 32 + cb * 16 + fr) * 2);
#pragma unroll
                            for (int j = 0; j < 8; ++j) af[cb][j] = (short)vp[j * 258]; }
#pragma unroll
                        for (int qb = 0; qb < 8; ++qb) { const s16x8 bfr = *(const LAS s16x8*)(wsl + (qb * 16 + fr) * 272 + ks * 64 + fq * 16);
                            acc[0][qb] = __builtin_amdgcn_mfma_f32_16x16x32_bf16(af[0], bfr, acc[0][qb], 0, 0, 0);
                            acc[1][qb] = __builtin_amdgcn_mfma_f32_16x16x32_bf16(af[1], bfr, acc[1][qb], 0, 0, 0); }
                    }
#pragma unroll
                    for (int qb = 0; qb < 8; ++qb) { const int q = qb * 16 + fr; const float bq = bqv[qb]; const size_t tok = (size_t)(row0 + q);
#pragma unroll
                        for (int cb = 0; cb < 2; ++cb) { const int ch = c0 + wave * 32 + cb * 16 + fq * 4;
                            const v2u u2 = uu[qb][cb];
                            const f32x4 sv = acc[cb][qb] + bq;
                            *(v2u*)(GB + tok * 2048 + ch) = (v2u){pk2(bf_lo(u2.x) * sv[0], bf_hi(u2.x) * sv[1]), pk2(bf_lo(u2.y) * sv[2], bf_hi(u2.y) * sv[3])}; } }
                    __syncthreads();
                }
#undef SP_PREFETCH
            }
            PHASE_END
            PHASE_BEGIN
            {
                pg8::Gemm g{GB, WOUTT, MLAT, DM, 2048, 2048, 0, 2048}; pg8::StaticOrder S; S.init(MLAT, DM, G, bx);
                pg8::EpiRes E{nullptr, nullptr, H16, modl + 2 * 1024, nullptr, AB, ng1, modl + 4 * 1024, SSQ};
                pg8::gemm_phase<pg8::EpiRes, pg8::StaticOrder>(L, g, S, E, tid);
            }
            PHASE_END
        }
        PHASE_BEGIN_C(5)
        {
            pg8::Gemm g{AB, W1T + (size_t)layer * DM * DFF, nrows, DFF, DM, DM, 0, DM}; pg8::StaticOrder S; S.init(nrows, DFF, G, bx);
            pg8::EpiBf16<1> E{FB, DFF, nullptr, SSQ, BI_W1 + (size_t)layer * 3 * 4096, 4096};
            pg8::gemm_phase<pg8::EpiBf16<1>, pg8::StaticOrder>(L, g, S, E, tid);
            if (layer == 0) { const int fi = TAIL_FIRST(MALL / 256 * 16);
                if (bx >= fi) { LAS float* scr = (LAS float*)(L + wave * 16640); TR_RUN(2, 4096, (bx - fi) * NWAVES + wave, (G - fi) * NWAVES); } }
        }
        PHASE_END
        PHASE_BEGIN
        {
            if (layer == 0) {
                pg8::Gemm g{FB, W2T, MALL, DM, DFF, DFF, 0, DFF}; pg8::SplitOrder S; S.init(G, bx);
                pg8::EpiResSplit E{{nullptr, nullptr, H16, modl + 5 * 1024, nullptr, AB, ng0 + 2 * DM, modl + 3 * 6144 + 1024, SSQ}, CACC};
                pg8::gemm_phase<pg8::EpiResSplit, pg8::SplitOrder>(L, g, S, E, tid);
                { const int fi = TAIL_FIRST(MLAT / 256 * 4 + 32);
                  if (bx >= fi) { LAS float* scr = (LAS float*)(L + wave * 16640); TR_RUN(3, 3584, (bx - fi) * NWAVES + wave, (G - fi) * NWAVES);
                      BIAS_RUN(16384, 18432, (bx - fi) * NWAVES + wave, (G - fi) * NWAVES); } }
            } else {
                pg8::Gemm g{FB, W2T + (size_t)layer * DM * DFF, MLAT, DM, DFF, DFF, 0, DFF}; pg8::StaticOrder S; S.init(MLAT, DM, G, bx);
                pg8::EpiRes E{nullptr, nullptr, H16, modl + 5 * 1024, nullptr, next_hb ? AB : nullptr, ng0 + 2 * DM, modl + 3 * 6144 + 1024, SSQ};
                pg8::gemm_phase<pg8::EpiRes, pg8::StaticOrder>(L, g, S, E, tid);
            }
        }
        PHASE_END
        if (layer == 0) {
            PHASE_BEGIN
            {
                const float* wg = ng0 + 2 * DM; const float* wsc = modl + 3 * 6144 + 1024 + 2 * 6144;
                for (int r = gw; r < MCTX; r += NGW) { const f32x4* xr = (const f32x4*)(CACC + (size_t)r * DM) + lane; unsigned long long* h8 = (unsigned long long*)(H16 + (size_t)(MLAT + r) * DM) + lane; f32x4 v[4]; float ss = 0.f;
#pragma unroll
                    for (int j = 0; j < 4; ++j) { const unsigned long long hw_ = h8[64 * j]; const unsigned lo_ = (unsigned)hw_, hi_ = (unsigned)(hw_ >> 32);
                        v[j] = (f32x4){bf_lo(lo_), bf_hi(lo_), bf_lo(hi_), bf_hi(hi_)} + ((xr[64 * j] + xr[64 * j + MCTX * DM / 4]) + (xr[64 * j + 2 * (MCTX * DM / 4)] + xr[64 * j + 3 * (MCTX * DM / 4)]));
                        h8[64 * j] = (unsigned long long)pk2(v[j][0], v[j][1]) | ((unsigned long long)pk2(v[j][2], v[j][3]) << 32);
                        ss += (v[j][0] * v[j][0] + v[j][1] * v[j][1]) + (v[j][2] * v[j][2] + v[j][3] * v[j][3]); }
                    ss = wave_sum(ss); if (lane < 16) SSQ[(size_t)(MLAT + r) * 16 + lane] = lane == 0 ? ss : 0.f;
                    unsigned long long* o8 = (unsigned long long*)(AB + (size_t)(MLAT + r) * DM) + lane;
#pragma unroll
                    for (int j = 0; j < 4; ++j) { const f32x4 y = v[j] * (*(const f32x4*)(wg + 4 * lane + 256 * j)) * (*(const f32x4*)(wsc + 4 * lane + 256 * j) + 1.0f);
                        o8[64 * j] = (unsigned long long)pk2(y[0], y[1]) | ((unsigned long long)pk2(y[2], y[3]) << 32); } }
            }
            PHASE_END
        }
    }
    PHASE_BEGIN
    {
        f32x4 g4[4];
#pragma unroll
        for (int j = 0; j < 4; ++j) g4[j] = *(const f32x4*)(A_->final_g + 4 * lane + 256 * j);
        for (int row = gw; row < MLAT; row += 4 * NGW) {
            int rw[4]; unsigned long long rr[4][4];
#pragma unroll
            for (int k = 0; k < 4; ++k) { rw[k] = row + k * NGW < MLAT ? row + k * NGW : row; const unsigned long long* hp = (const unsigned long long*)(H16 + (size_t)rw[k] * DM) + lane;
#pragma unroll
                for (int j = 0; j < 4; ++j) rr[k][j] = hp[64 * j]; }
#pragma unroll
            for (int k = 0; k < 4; ++k) { f32x4 v[4]; float ss = 0.f;
#pragma unroll
                for (int j = 0; j < 4; ++j) { const unsigned lo_ = (unsigned)rr[k][j], hi_ = (unsigned)(rr[k][j] >> 32);
                    v[j] = (f32x4){bf_lo(lo_), bf_hi(lo_), bf_lo(hi_), bf_hi(hi_)}; ss += (v[j][0] * v[j][0] + v[j][1] * v[j][1]) + (v[j][2] * v[j][2] + v[j][3] * v[j][3]); }
#pragma unroll
                for (int o = 1; o < 64; o <<= 1) ss += __shfl_xor(ss, o);
                const float rs = rsqrtf(ss * (1.f / DM) + EPS);
                f32x4* op = (f32x4*)(A_->out + (size_t)rw[k] * DM) + lane;
#pragma unroll
                for (int j = 0; j < 4; ++j) op[64 * j] = v[j] * rs * g4[j]; }
        }
    }
    PHASE_END
#undef PHASE_BEGIN
#undef TR_DECODE
#undef TR_SETMAP
#undef TR_RUN
#undef BIAS_RUN
#undef TAIL_FIRST
#undef PHASE_BEGIN_C
#undef PHASE_END
}

constexpr int N_PHASES = 1 + (2 + 3) + (3 + 2) + (3 + 2) + (2 + 2) + 1;

extern "C" void kernel_launch(void* const* d_in, const int* in_sizes, int n_in, void* d_out, int out_size, void* d_ws, size_t ws_size, hipStream_t stream) {
    static int grid = 0;
    if (grid == 0) {
        if (n_in != 22 || out_size != MLAT * DM || ws_size < WS_END) { fprintf(stderr, "kernel_launch: unexpected shapes: n_in %d out %d ws %zu (need %zu)\n", n_in, out_size, ws_size, (size_t)WS_END); grid = -1; return; }
        int dev = 0, cus = 0, per_cu = 0;
        hipGetDevice(&dev); hipDeviceGetAttribute(&cus, hipDeviceAttributeMultiprocessorCount, dev);
        if (hipFuncSetAttribute((const void*)fwd_kernel, hipFuncAttributeMaxDynamicSharedMemorySize, LDS_BYTES) != hipSuccess) { fprintf(stderr, "kernel_launch: hipFuncSetAttribute failed\n"); grid = -1; return; }
        if (hipOccupancyMaxActiveBlocksPerMultiprocessor(&per_cu, (const void*)fwd_kernel, NWAVES * 64, LDS_BYTES) != hipSuccess || per_cu < 1) { fprintf(stderr, "kernel_launch: occupancy query gave %d\n", per_cu); per_cu = 1; }
        (void)hipGetLastError();
        grid = cus * per_cu;
        fprintf(stderr, "kernel_launch: grid %d (cus %d x %d)\n", grid, cus, per_cu);
    }
    if (grid < 0) return;
    Args a{};
    const float** ap = (const float**)&a;
    for (int i = 0; i < 22; ++i) ap[i] = (const float*)d_in[i];
    a.out = (float*)d_out; a.ws = (unsigned char*)d_ws;
#if MK_N_LAUNCHES == 1
    a.ph_lo = 0; a.ph_hi = N_PHASES;
    if (hipMemsetAsync((char*)d_ws + WS_BAR, 0, XCD_BAR_WORDS * 4, stream) != hipSuccess) fprintf(stderr, "kernel_launch: memset of barrier words failed\n");
    void* kargs[] = {&a};
    hipError_t e = hipLaunchCooperativeKernel((const void*)fwd_kernel, dim3(grid), dim3(NWAVES * 64), kargs, LDS_BYTES, stream);
    if (e != hipSuccess) fprintf(stderr, "kernel_launch: cooperative launch failed: %s (grid %d)\n", hipGetErrorString(e), grid);
#else
    for (int p = 0; p < N_PHASES; ++p) { a.ph_lo = p; a.ph_hi = p + 1;
        hipLaunchKernelGGL(fwd_kernel, dim3(grid), dim3(NWAVES * 64), LDS_BYTES, stream, a); }
#endif
}
```

```cpp
#include <hip/hip_runtime.h>
#include <hip/hip_cooperative_groups.h>
#include <hip/hip_bf16.h>
#include <cstdio>
#include <cstdint>
namespace cg = cooperative_groups;

#ifndef PROBE_MASK
#define PROBE_MASK 0u
#endif
#ifndef MK_N_LAUNCHES
#define MK_N_LAUNCHES 1
#endif

constexpr int DM = 1024, SEQ = 8192, NB = 2, CTXL = 256, DFF = 4096, DEPTH = 4;
constexpr int MLAT = NB * SEQ;
constexpr int MCTX = NB * CTXL;
constexpr int MALL = MLAT + MCTX;
constexpr int SKV = CTXL + SEQ;
constexpr float EPS = 1e-6f;

namespace pg8 {
#define PG8_LAS __attribute__((address_space(3)))
typedef unsigned short bf16_t;
typedef short bf16x8 __attribute__((ext_vector_type(8)));
typedef float f32x4 __attribute__((ext_vector_type(4)));
typedef float f32x2 __attribute__((ext_vector_type(2)));
typedef unsigned u32x4 __attribute__((ext_vector_type(4)));
typedef unsigned u32x2 __attribute__((ext_vector_type(2)));
constexpr int BM = 256, BK = 64, HALF = 128, HTB = HALF * BK * 2, STAGE_BYTES = 8 * HTB, NXCD = 8, WGM = 4;

__host__ __device__ __forceinline__ int lds_byte(int r, int c) { const int st = (r >> 4) * 2 + (c >> 5), rr = r & 15, cc = c & 31, ob = rr * 64 + cc * 2; return st * 1024 + (ob ^ (((ob >> 9) & 1) << 5)); }
__host__ __device__ __forceinline__ void stage_rc(int b, int& R, int& C) { const int st = b / 1024, sb = b % 1024, swz = sb ^ (((sb >> 9) & 1) << 5); R = (st >> 1) * 16 + swz / 64; C = (st & 1) * 32 + (swz % 64) / 2; }
__host__ __device__ __forceinline__ int perm32(int rho) { const int n = rho >> 4, i = rho & 15; return 8 * (i >> 2) + 4 * n + (i & 3); }

struct Unit { int pm, pn, ks; };
struct Gemm { const bf16_t* A; const bf16_t* Bt; int M, N, K, lda, a_pn_off, ldb; };

struct StaticOrder {
    int nM, nN, nwg, G, c;
    __host__ __device__ void init(int M, int N, int G_, int c_) { nM = M / BM; nN = N / BM; nwg = nM * nN; G = G_; c = c_; }
    __host__ __device__ bool next(int i, Unit& u) const {
        const long L = (long)i * G + c; if (L >= nwg) return false;
        int wgid = (int)L; { const int q = nwg / NXCD, r = nwg % NXCD, xcd = wgid % NXCD, off = wgid / NXCD; wgid = (xcd < r ? xcd * (q + 1) : r * (q + 1) + (xcd - r) * q) + off; }
        const int nig = WGM * nN, gid = wgid / nig, fm = gid * WGM, gsz = (nM - fm) < WGM ? (nM - fm) : WGM;
        u.pm = fm + ((wgid % nig) % gsz); u.pn = (wgid % nig) / gsz; return true;
    }
    __device__ __forceinline__ size_t koff(const Unit&) const { return 0; }
    __device__ __forceinline__ int nt(const Unit&, int d) const { return d; }
};
struct SplitOrder {
    StaticOrder so; int G, c;
    __device__ void init(int G_, int c_) { so.init(MLAT, DM, G_, c_); G = G_; c = c_; }
    __device__ bool next(int i, Unit& u) const {
        const long L = (long)i * G + c;
        if (L < so.nwg) { const bool r = so.next(i, u); u.ks = 0; return r; }
        const int j = (int)(L - so.nwg); if (j >= 32) return false;
        u.pm = 64 + (j >> 4); u.pn = (j >> 2) & 3; u.ks = j & 3; return true;
    }
    __device__ __forceinline__ size_t koff(const Unit& u) const { return u.pm >= 64 ? (size_t)u.ks * 2048 : 0; }
    __device__ __forceinline__ int nt(const Unit& u, int d) const { return u.pm >= 64 ? 16 : d; }
};

__device__ __forceinline__ unsigned cvt_pk_bf16(float lo, float hi) { unsigned r; asm volatile("v_cvt_pk_bf16_f32 %0, %1, %2" : "=v"(r) : "v"(lo), "v"(hi)); return r; }
__device__ __forceinline__ float gelu_tanh(float x) {
    const float u = x * (0.7978845608f + 0.0356774081f * x * x);
    const float e = __builtin_amdgcn_exp2f(u * 2.8853900818f);
    return x - x * __builtin_amdgcn_rcpf(e + 1.0f);
}

template <int ACT  > struct EpiBf16 {
    static constexpr bool PERM = true;
    bf16_t* O; int ldc; float* stats; const float* ssq; const float* bias; int nbias;
    __device__ __forceinline__ void operator()(const f32x4 (&acc)[2][2][4][2], const Unit& u, int wr, int wc, int fr, int fq) const {
        const int rowt = u.pm * BM, b = rowt >= MLAT ? 2 : (rowt >> 13);
        const int row0 = rowt + wr * 64 + fr, col0 = u.pn * BM + wc * 32 + 8 * fq;
        f32x4 bv[2][2];
#pragma unroll
        for (int bj = 0; bj < 2; ++bj)
#pragma unroll
            for (int n = 0; n < 2; ++n) bv[bj][n] = *(const f32x4*)(bias + (size_t)b * nbias + col0 + bj * HALF + 4 * n);
        float rsv[2][4];
        { f32x4 pq[2][4];
#pragma unroll
          for (int ai = 0; ai < 2; ++ai)
#pragma unroll
              for (int m = 0; m < 4; ++m) pq[ai][m] = *(const f32x4*)(ssq + (size_t)(row0 + ai * HALF + m * 16) * 16 + 4 * fq);
#pragma unroll
          for (int ai = 0; ai < 2; ++ai)
#pragma unroll
              for (int m = 0; m < 4; ++m) { float t = (pq[ai][m][0] + pq[ai][m][1]) + (pq[ai][m][2] + pq[ai][m][3]); t += __shfl_xor(t, 16); t += __shfl_xor(t, 32);
                  rsv[ai][m] = rsqrtf(t * (1.f / DM) + EPS); } }
#pragma unroll
        for (int ai = 0; ai < 2; ++ai)
#pragma unroll
            for (int m = 0; m < 4; ++m) { const int row = row0 + ai * HALF + m * 16; bf16_t* rowp = O + (size_t)row * ldc + col0; float s = 0.f, q = 0.f;
                const float rstd = rsv[ai][m];
#pragma unroll
                for (int bj = 0; bj < 2; ++bj) { f32x4 v0 = acc[ai][bj][m][0] * rstd + bv[bj][0], v1 = acc[ai][bj][m][1] * rstd + bv[bj][1];
                    if (ACT == 1) {
#pragma unroll
                        for (int e = 0; e < 4; ++e) { const float a = fmaxf(v0[e], 0.f), b2 = fmaxf(v1[e], 0.f); v0[e] = a * a; v1[e] = b2 * b2; } }
                    if (ACT == 2) {
#pragma unroll
                        for (int e = 0; e < 4; ++e) { v0[e] = gelu_tanh(v0[e]); v1[e] = gelu_tanh(v1[e]); s += v0[e] + v1[e]; q += v0[e] * v0[e] + v1[e] * v1[e]; } }
                    u32x4 w; w.x = cvt_pk_bf16(v0[0], v0[1]); w.y = cvt_pk_bf16(v0[2], v0[3]); w.z = cvt_pk_bf16(v1[0], v1[1]); w.w = cvt_pk_bf16(v1[2], v1[3]);
                    *(u32x4*)(rowp + bj * HALF) = w; }
                if (ACT == 2) { if (u.pn >= 8) { s += __shfl_xor(s, 16); s += __shfl_xor(s, 32); q += __shfl_xor(q, 16); q += __shfl_xor(q, 32);
                    if (fq == 0) *(f32x2*)(stats + ((size_t)row * 32 + (u.pn - 8) * 4 + wc) * 2) = (f32x2){s, q}; } }
            }
    }
};
struct EpiRes {
    static constexpr bool PERM = true;
    const float* base_lat; const float* base_ctx;   bf16_t* h16; const float* gate;   const float* cs;
    bf16_t* hb; const float* wn_g; const float* wn_sc;   float* ssq;
    __device__ __forceinline__ void operator()(const f32x4 (&acc)[2][2][4][2], const Unit& u, int wr, int wc, int fr, int fq) const {
        asm volatile("" : "+v"(fr), "+v"(fq));
        const int rowt = u.pm * BM, b = rowt >= MLAT ? 2 : (rowt >> 13);
        const float* gp = gate + b * 6144; const int col0 = u.pn * BM + wc * 32 + 8 * fq;
        f32x4 gv[2][2], wv[2][2];
#pragma unroll
        for (int bj = 0; bj < 2; ++bj)
#pragma unroll
            for (int n = 0; n < 2; ++n) { gv[bj][n] = *(const f32x4*)(gp + col0 + bj * HALF + n * 4); if (cs) gv[bj][n] = gv[bj][n] * *(const f32x4*)(cs + col0 + bj * HALF + n * 4);
                if (hb) wv[bj][n] = *(const f32x4*)(wn_g + col0 + bj * HALF + n * 4) * (*(const f32x4*)(wn_sc + b * 6144 + col0 + bj * HALF + n * 4) + 1.0f); }
        const float* bb = base_lat ? (rowt >= MLAT ? base_ctx + (size_t)(rowt - MLAT) * DM : base_lat + (size_t)rowt * DM) : nullptr;
#pragma unroll
        for (int ai = 0; ai < 2; ++ai) {
            u32x4 raw[4][2];
#pragma unroll
            for (int m = 0; m < 4; ++m)
#pragma unroll
                for (int bj = 0; bj < 2; ++bj) raw[m][bj] = *(const u32x4*)(h16 + (size_t)rowt * DM + (size_t)(wr * 64 + fr + ai * HALF + m * 16) * DM + col0 + bj * HALF);
#pragma unroll
            for (int m = 0; m < 4; ++m) { const int rl = wr * 64 + fr + ai * HALF + m * 16; const size_t off = (size_t)rl * DM + col0; float sq = 0.f;
                bf16_t* hrow = h16 + (size_t)rowt * DM + off;
#pragma unroll
                for (int bj = 0; bj < 2; ++bj) { f32x4 b0, b1;
                    if (bb) { b0 = *(const f32x4*)(bb + off + bj * HALF); b1 = *(const f32x4*)(bb + off + bj * HALF + 4); }
                    else { const u32x4 r = raw[m][bj];
                        b0 = (f32x4){__uint_as_float(r.x << 16), __uint_as_float(r.x & 0xffff0000u), __uint_as_float(r.y << 16), __uint_as_float(r.y & 0xffff0000u)};
                        b1 = (f32x4){__uint_as_float(r.z << 16), __uint_as_float(r.z & 0xffff0000u), __uint_as_float(r.w << 16), __uint_as_float(r.w & 0xffff0000u)}; }
                    const f32x4 o0 = b0 + gv[bj][0] * acc[ai][bj][m][0], o1 = b1 + gv[bj][1] * acc[ai][bj][m][1];
                    u32x4 w; w.x = cvt_pk_bf16(o0[0], o0[1]); w.y = cvt_pk_bf16(o0[2], o0[3]); w.z = cvt_pk_bf16(o1[0], o1[1]); w.w = cvt_pk_bf16(o1[2], o1[3]);
                    *(u32x4*)(hrow + bj * HALF) = w;
                    sq += ((o0[0] * o0[0] + o0[1] * o0[1]) + (o0[2] * o0[2] + o0[3] * o0[3])) + ((o1[0] * o1[0] + o1[1] * o1[1]) + (o1[2] * o1[2] + o1[3] * o1[3]));
                    if (hb) { const f32x4 y0 = o0 * wv[bj][0], y1 = o1 * wv[bj][1]; u32x4 z; z.x = cvt_pk_bf16(y0[0], y0[1]); z.y = cvt_pk_bf16(y0[2], y0[3]); z.z = cvt_pk_bf16(y1[0], y1[1]); z.w = cvt_pk_bf16(y1[2], y1[3]);
                        *(u32x4*)(hb + (size_t)rowt * DM + off + bj * HALF) = z; } }
                if (ssq) { sq += __shfl_xor(sq, 16); sq += __shfl_xor(sq, 32); if (fq == 0) ssq[(size_t)(rowt + rl) * 16 + u.pn * 4 + wc] = sq; } }
        }
    }
};

struct EpiResSplit {
    static constexpr bool PERM = true;
    EpiRes base; float* cacc;
    __device__ __forceinline__ void operator()(const f32x4 (&acc)[2][2][4][2], const Unit& u, int wr, int wc, int fr, int fq) const {
        if (u.pm < 64) { base(acc, u, wr, wc, fr, fq); return; }
        asm volatile("" : "+v"(fr), "+v"(fq));
        const int rowt = u.pm * BM, col0 = u.pn * BM + wc * 32 + 8 * fq;
        const float* gp = base.gate + 2 * 6144;
        float* ob = cacc + (size_t)u.ks * MCTX * DM + (size_t)(rowt - MLAT) * DM;
        f32x4 gv[2][2];
#pragma unroll
        for (int bj = 0; bj < 2; ++bj)
#pragma unroll
            for (int n = 0; n < 2; ++n) gv[bj][n] = *(const f32x4*)(gp + col0 + bj * HALF + n * 4);
#pragma unroll
        for (int ai = 0; ai < 2; ++ai)
#pragma unroll
            for (int m = 0; m < 4; ++m) { float* o = ob + (size_t)(wr * 64 + fr + ai * HALF + m * 16) * DM + col0; asm volatile("" : "+v"(o));
#pragma unroll
                for (int bj = 0; bj < 2; ++bj)
#pragma unroll
                    for (int n = 0; n < 2; ++n) *(f32x4*)(o + bj * HALF + n * 4) = gv[bj][n] * acc[ai][bj][m][n]; }
    }
};

struct EpiQKV {
    static constexpr bool PERM = true;
    bf16_t* Q; bf16_t* K; bf16_t* V; const float* ssq; const float* bias; const float* qg; const float* kg; PG8_LAS float* P;
    __device__ __forceinline__ void operator()(f32x4 (&acc)[2][2][4][2], const Unit& u, int wr, int wc, int fr, int fq) const {
        asm volatile("" : "+v"(fr), "+v"(fq));
        const int rowt = u.pm * BM, b = rowt >= MLAT ? 2 : (rowt >> 13); const bool is_lat = rowt < MLAT;
        if (!is_lat && u.pn < 4) return;
        const int col0 = u.pn * BM + wc * 32 + 8 * fq;
        const bool qk = u.pn < 6;
        {   f32x4 bv[2][2];
#pragma unroll
            for (int bj = 0; bj < 2; ++bj)
#pragma unroll
                for (int n = 0; n < 2; ++n) bv[bj][n] = *(const f32x4*)(bias + (size_t)b * 2048 + col0 + bj * HALF + 4 * n);
            float rsv[2][4];
            { f32x4 pq[2][4];
#pragma unroll
              for (int ai = 0; ai < 2; ++ai)
#pragma unroll
                  for (int m = 0; m < 4; ++m) pq[ai][m] = *(const f32x4*)(ssq + (size_t)(rowt + wr * 64 + fr + ai * HALF + m * 16) * 16 + 4 * fq);
#pragma unroll
              for (int ai = 0; ai < 2; ++ai)
#pragma unroll
                  for (int m = 0; m < 4; ++m) { float t = (pq[ai][m][0] + pq[ai][m][1]) + (pq[ai][m][2] + pq[ai][m][3]); t += __shfl_xor(t, 16); t += __shfl_xor(t, 32);
                      rsv[ai][m] = rsqrtf(t * (1.f / DM) + EPS); } }
#pragma unroll
            for (int ai = 0; ai < 2; ++ai)
#pragma unroll
                for (int m = 0; m < 4; ++m) { const int rl = wr * 64 + fr + ai * HALF + m * 16;
                    const float rstd = rsv[ai][m];
#pragma unroll
                    for (int bj = 0; bj < 2; ++bj) { const f32x4 v0 = acc[ai][bj][m][0] * rstd + bv[bj][0], v1 = acc[ai][bj][m][1] * rstd + bv[bj][1];
                        acc[ai][bj][m][0] = v0; acc[ai][bj][m][1] = v1;
                        if (qk) { float sq = ((v0[0] * v0[0] + v0[1] * v0[1]) + (v0[2] * v0[2] + v0[3] * v0[3])) + ((v1[0] * v1[0] + v1[1] * v1[1]) + (v1[2] * v1[2] + v1[3] * v1[3]));
                            sq += __shfl_xor(sq, 16); sq += __shfl_xor(sq, 32); if (fq == 0) P[(rl * 2 + bj) * 4 + wc] = sq; } } }
        }
        if (qk) { asm volatile("s_waitcnt lgkmcnt(0)" ::: "memory"); __builtin_amdgcn_s_barrier(); asm volatile("" ::: "memory"); }
        float gq[2][4], inv[2][2];
        { const float* gsrc = u.pn < 4 ? qg : kg;
#pragma unroll
          for (int n = 0; n < 2; ++n) {
#pragma unroll
            for (int e = 0; e < 4; ++e) { const int p = wc * 32 + 8 * fq + 4 * n + e; gq[n][e] = gsrc[(p >> 6) * 64 + (p & 1) * 32 + ((p & 63) >> 1)]; }
#pragma unroll
            for (int pr = 0; pr < 2; ++pr) inv[n][pr] = __builtin_amdgcn_exp2f(-(float)(16 * (wc & 1) + 4 * fq + 2 * n + pr) * 0.4152410118609203f); } }
        const int headbase = (u.pn & 1) * 2;
#pragma unroll
        for (int ai = 0; ai < 2; ++ai)
#pragma unroll
            for (int m = 0; m < 4; ++m) { const int rl = wr * 64 + fr + ai * HALF + m * 16, row = rowt + rl;
                int kvrow; float cs[2][2], sn[2][2];
                if (is_lat) { const int t = row & (SEQ - 1); kvrow = b * SKV + CTXL + t; const float pos = (float)((wc >> 1) ? (t & 63) : (t >> 6));
#pragma unroll
                    for (int n = 0; n < 2; ++n)
#pragma unroll
                        for (int pr = 0; pr < 2; ++pr) { const float a = pos * inv[n][pr]; cs[n][pr] = __cosf(a); sn[n][pr] = __sinf(a); } }
                else { kvrow = ((row - MLAT) >> 8) * SKV + ((row - MLAT) & (CTXL - 1));
#pragma unroll
                    for (int n = 0; n < 2; ++n)
#pragma unroll
                        for (int pr = 0; pr < 2; ++pr) { cs[n][pr] = 1.f; sn[n][pr] = 0.f; } }
#pragma unroll
                for (int bj = 0; bj < 2; ++bj) { f32x4 v0 = acc[ai][bj][m][0], v1 = acc[ai][bj][m][1]; bf16_t* dst;
                    if (qk) { const f32x4 pt = *(const PG8_LAS f32x4*)(P + (rl * 2 + bj) * 4);
                        const float hr = rsqrtf(((pt[0] + pt[1]) + (pt[2] + pt[3])) * (1.f / 128.f) + EPS);
#pragma unroll
                        for (int e = 0; e < 4; ++e) { v0[e] = v0[e] * hr * gq[0][e]; v1[e] = v1[e] * hr * gq[1][e]; }
                        const f32x4 r0 = {v0[0] * cs[0][0] - v0[1] * sn[0][0], v0[0] * sn[0][0] + v0[1] * cs[0][0], v0[2] * cs[0][1] - v0[3] * sn[0][1], v0[2] * sn[0][1] + v0[3] * cs[0][1]};
                        const f32x4 r1 = {v1[0] * cs[1][0] - v1[1] * sn[1][0], v1[0] * sn[1][0] + v1[1] * cs[1][0], v1[2] * cs[1][1] - v1[3] * sn[1][1], v1[2] * sn[1][1] + v1[3] * cs[1][1]};
                        v0 = r0; v1 = r1;
                        dst = u.pn < 4 ? Q + (size_t)row * DM + (u.pn * 2 + bj) * 128 : K + (size_t)kvrow * 512 + ((u.pn - 4) * 2 + bj) * 128;
                    } else dst = V + (size_t)kvrow * 512 + ((u.pn - 6) * 2 + bj) * 128;
                    u32x4 w; w.x = cvt_pk_bf16(v0[0], v0[1]); w.y = cvt_pk_bf16(v0[2], v0[3]); w.z = cvt_pk_bf16(v1[0], v1[1]); w.w = cvt_pk_bf16(v1[2], v1[3]);
                    *(u32x4*)(dst + wc * 32 + 8 * fq) = w; } }
        (void)headbase;
    }
};

template <class Epi, class Sched>
__device__ __forceinline__ void gemm_phase(PG8_LAS unsigned char* lds, const Gemm g, const Sched& S, const Epi& E, const int tid) {
    const int wid = __builtin_amdgcn_readfirstlane(tid >> 6), lane = tid & 63, wr = wid >> 2, wc = wid & 3, fr = lane & 15, fq = lane >> 4;
    const int K = g.K, nt = K / BK, lda = g.lda, ldb = g.ldb;
    unsigned voffA[2], voffB[2];
#pragma unroll
    for (int i = 0; i < 2; ++i) { int R, C; stage_rc(tid * 16 + i * 8192, R, C); const int Rb = Epi::PERM ? ((R & ~31) + perm32(R & 31)) : R;
        voffA[i] = (unsigned)(R * lda + C) * 2u; voffB[i] = (unsigned)(Rb * ldb + C) * 2u; }
    const size_t kstep = (size_t)(BK * 2);
    const size_t hstepA = (size_t)HALF * lda * 2, hstepB = (size_t)HALF * ldb * 2;
    const size_t tstepA = 2 * hstepA, tstepB = 2 * hstepB;
    const unsigned ldsw = (unsigned)wid * 1024u;
    const int aoff = lds_byte(wr * 64 + fr, fq * 8), boff = lds_byte(wc * 32 + fr, fq * 8);
#define PG8_SA(b, h) (((b) * 2 + (h)) * HTB)
#define PG8_SB(b, h) ((4 + (b) * 2 + (h)) * HTB)
#define PG8_STAGE(bufoff, gbase, voff) do { _Pragma("unroll") for (int _i = 0; _i < 2; ++_i) \
        __builtin_amdgcn_global_load_lds((const unsigned*)((const char*)(gbase) + (voff)[_i]), (PG8_LAS unsigned*)(lds + (bufoff) + ldsw + _i * 8192), 16, 0, 0); } while (0)
#define PG8_LDA(dst, b, h) do { _Pragma("unroll") for (int m = 0; m < 4; ++m) _Pragma("unroll") for (int k = 0; k < 2; ++k) dst[m][k] = *(const PG8_LAS bf16x8*)(lds + PG8_SA(b, h) + aoff + m * 2048 + k * 1024); } while (0)
#define PG8_LDB(dst, b, h) do { _Pragma("unroll") for (int n = 0; n < 2; ++n) _Pragma("unroll") for (int k = 0; k < 2; ++k) dst[n][k] = *(const PG8_LAS bf16x8*)(lds + PG8_SB(b, h) + boff + n * 2048 + k * 1024); } while (0)
#define PG8_MMA(ai, bj, At, Bt) do { __builtin_amdgcn_s_setprio(1); _Pragma("unroll") for (int m = 0; m < 4; ++m) _Pragma("unroll") for (int n = 0; n < 2; ++n) _Pragma("unroll") for (int k = 0; k < 2; ++k) \
        acc[ai][bj][m][n] = __builtin_amdgcn_mfma_f32_16x16x32_bf16(Bt[n][k], At[m][k], acc[ai][bj][m][n], 0, 0, 0); __builtin_amdgcn_s_setprio(0); } while (0)
#define PG8_WAIT_V(n) asm volatile("s_waitcnt vmcnt(" #n ")" ::: "memory")
#define PG8_WAIT_L(n) asm volatile("s_waitcnt lgkmcnt(" #n ")" ::: "memory")
#define PG8_BAR __builtin_amdgcn_s_barrier()
#define PG8_SCHED __builtin_amdgcn_sched_barrier(0)
    Unit cur, nxt; int ui = 0;
    if (!S.next(0, cur)) return;
    f32x4 acc[2][2][4][2];
#pragma unroll
    for (int a = 0; a < 2; ++a)
#pragma unroll
        for (int b = 0; b < 2; ++b)
#pragma unroll
            for (int m = 0; m < 4; ++m)
#pragma unroll
                for (int n = 0; n < 2; ++n) acc[a][b][m][n] = (f32x4){0.f, 0.f, 0.f, 0.f};
    bf16x8 At[4][2], B0[2][2], B1[2][2];
    const char* cA = (const char*)g.A + (size_t)cur.pm * tstepA + (size_t)cur.pn * g.a_pn_off + S.koff(cur); const char* cB = (const char*)g.Bt + (size_t)cur.pn * tstepB + S.koff(cur);
    PG8_STAGE(PG8_SB(0, 0), cB, voffB); PG8_STAGE(PG8_SB(0, 1), cB + hstepB, voffB); PG8_STAGE(PG8_SA(0, 0), cA, voffA); PG8_STAGE(PG8_SA(0, 1), cA + hstepA, voffA);
    if (wr == 1) PG8_BAR;
    PG8_WAIT_V(2); PG8_BAR;
    PG8_STAGE(PG8_SB(1, 0), cB + kstep, voffB); PG8_STAGE(PG8_SA(1, 0), cA + kstep, voffA); PG8_STAGE(PG8_SB(1, 1), cB + hstepB + kstep, voffB);
    PG8_WAIT_V(6); PG8_BAR;
    for (;;) {
        const bool has_next = S.next(ui + 1, nxt);
        const char* nA = has_next ? (const char*)g.A + (size_t)nxt.pm * tstepA + (size_t)nxt.pn * g.a_pn_off + S.koff(nxt) : cA; const char* nB = has_next ? (const char*)g.Bt + (size_t)nxt.pn * tstepB + S.koff(nxt) : cB;
        const int ntc = S.nt(cur, nt);
        for (int t = 0; t < ntc; t += 2) {
            const bool last = (t == ntc - 2);
            const char* a1 = cA + (size_t)(t + 1) * kstep;
            const char* a2 = last ? nA : cA + (size_t)(t + 2) * kstep; const char* b2 = last ? nB : cB + (size_t)(t + 2) * kstep;
            const char* a3 = a2 + kstep; const char* b3 = b2 + kstep;
            PG8_LDB(B0, 0, 0); PG8_LDB(B1, 0, 1); PG8_SCHED; PG8_LDA(At, 0, 0); PG8_STAGE(PG8_SA(1, 1), a1 + hstepA, voffA);
            PG8_WAIT_V(8); PG8_WAIT_L(0); PG8_BAR; PG8_MMA(0, 0, At, B0); PG8_MMA(0, 1, At, B1); PG8_BAR; PG8_SCHED;
            PG8_LDA(At, 0, 1); PG8_STAGE(PG8_SB(0, 0), b2, voffB); PG8_STAGE(PG8_SB(0, 1), b2 + hstepB, voffB); PG8_STAGE(PG8_SA(0, 0), a2, voffA);
            PG8_WAIT_V(8); PG8_WAIT_L(0); PG8_BAR; PG8_MMA(1, 0, At, B0); PG8_MMA(1, 1, At, B1); PG8_BAR; PG8_SCHED;
            PG8_LDB(B0, 1, 0); PG8_LDB(B1, 1, 1); PG8_SCHED; PG8_LDA(At, 1, 0); PG8_STAGE(PG8_SA(0, 1), a2 + hstepA, voffA);
            PG8_WAIT_V(8); PG8_WAIT_L(0); PG8_BAR; PG8_MMA(0, 0, At, B0); PG8_MMA(0, 1, At, B1); PG8_BAR; PG8_SCHED;
            PG8_LDA(At, 1, 1); PG8_STAGE(PG8_SB(1, 0), b3, voffB); PG8_STAGE(PG8_SB(1, 1), b3 + hstepB, voffB); PG8_STAGE(PG8_SA(1, 0), a3, voffA);
            PG8_WAIT_V(8); PG8_WAIT_L(0); PG8_BAR; PG8_MMA(1, 0, At, B0); PG8_MMA(1, 1, At, B1); PG8_BAR; PG8_SCHED;
        }
        if (wr == 0) PG8_BAR;
        E(acc, cur, wr, wc, fr, fq);
        if (!has_next) break;
#pragma unroll
        for (int a = 0; a < 2; ++a)
#pragma unroll
            for (int b = 0; b < 2; ++b)
#pragma unroll
                for (int m = 0; m < 4; ++m)
#pragma unroll
                    for (int n = 0; n < 2; ++n) acc[a][b][m][n] = (f32x4){0.f, 0.f, 0.f, 0.f};
        cur = nxt; cA = nA; cB = nB; ++ui;
        if (wr == 1) PG8_BAR;
    }
    PG8_WAIT_V(0);
    PG8_BAR;
#undef PG8_SA
#undef PG8_SB
#undef PG8_STAGE
#undef PG8_LDA
#undef PG8_LDB
#undef PG8_MMA
#undef PG8_WAIT_V
#undef PG8_WAIT_L
#undef PG8_BAR
#undef PG8_SCHED
}
}

namespace attn {
using bf16 = __hip_bfloat16;
constexpr int D = 128, NW = 8, QBLK = 32, KVBLK = 64;
constexpr float SCALE = 0.088388347648318440f;
constexpr float THR = 8.f;
constexpr int SDEPTH = 2;
constexpr int LDQ = 1024, LDK = 512, LDO = 1024;
constexpr size_t SHM_V = KVBLK * D * 2, SHM_K = KVBLK * D * 2, SHM_ATTN = 2 * SHM_V + 2 * SHM_K + NW * 64 * 4;
using bf16x8 = __attribute__((ext_vector_type(8))) short;
using s16x4  = __attribute__((ext_vector_type(4))) short;
using f32x16 = __attribute__((ext_vector_type(16))) float;
using u32x4  = __attribute__((ext_vector_type(4))) unsigned;
#define KSWZ(row, colB) ((row) * 256 + ((colB) ^ (((row) & 7) << 4)))
#define SBAR() __builtin_amdgcn_sched_barrier(0)
__device__ __forceinline__ int crow(int r, int hi) { return (r & 3) + 8 * (r >> 2) + 4 * hi; }
__device__ __forceinline__ unsigned cvtpk(float lo, float hi) { unsigned r; asm volatile("v_cvt_pk_bf16_f32 %0, %1, %2" : "=v"(r) : "v"(lo), "v"(hi)); return r; }
__device__ __forceinline__ bf16x8 ld8(const bf16* p) { return *reinterpret_cast<const bf16x8*>(p); }

__device__ __forceinline__ void partialSM(f32x16& p0, f32x16& p1, float mnC) {
  constexpr float C = SCALE * 1.4426950408889634f;
#pragma unroll
  for (int r = 0; r < 16; ++r) p0[r] = fmaf(p0[r], C, mnC);
#pragma unroll
  for (int r = 0; r < 16; ++r) p1[r] = fmaf(p1[r], C, mnC);
#pragma unroll
  for (int r = 0; r < 16; ++r) p0[r] = __builtin_amdgcn_exp2f(p0[r]);
}
__device__ __forceinline__ void finishSM(f32x16& p0, f32x16& p1, float& l_reg, bf16x8& pa0, bf16x8& pa1, bf16x8& pa2, bf16x8& pa3) {
#pragma unroll
  for (int r = 0; r < 16; ++r) p1[r] = __builtin_amdgcn_exp2f(p1[r]);
  float ps = 0;
#pragma unroll
  for (int r = 0; r < 16; ++r) ps += p0[r];
#pragma unroll
  for (int r = 0; r < 16; ++r) ps += p1[r];
  l_reg += ps;
#define PK4(P, BASE, OUT) do { unsigned a0 = cvtpk(P[BASE + 0], P[BASE + 1]), a1 = cvtpk(P[BASE + 2], P[BASE + 3]);   \
    unsigned b0 = cvtpk(P[BASE + 4], P[BASE + 5]), b1 = cvtpk(P[BASE + 6], P[BASE + 7]);                              \
    auto r0 = __builtin_amdgcn_permlane32_swap(a0, b0, false, false); auto r1 = __builtin_amdgcn_permlane32_swap(a1, b1, false, false); \
    u32x4 w = {r0[0], r1[0], r0[1], r1[1]}; OUT = *reinterpret_cast<bf16x8*>(&w); } while (0)
  PK4(p0, 0, pa0); PK4(p0, 8, pa1); PK4(p1, 0, pa2); PK4(p1, 8, pa3);
#undef PK4
}
__device__ __forceinline__ void qkt(f32x16& p0, f32x16& p1, const bf16* Ks, const bf16x8* qr, int r32, int hi) {
  p0 = f32x16{}; p1 = f32x16{};
#pragma unroll
  for (int d0 = 0; d0 < 8; ++d0) { int cb = (d0 * 16 + hi * 8) * 2;
    bf16x8 b0 = *reinterpret_cast<const bf16x8*>((const char*)Ks + KSWZ(r32, cb));
    bf16x8 b1 = *reinterpret_cast<const bf16x8*>((const char*)Ks + KSWZ(32 + r32, cb));
    p0 = __builtin_amdgcn_mfma_f32_32x32x16_bf16(b0, qr[d0], p0, 0, 0, 0);
    p1 = __builtin_amdgcn_mfma_f32_32x32x16_bf16(b1, qr[d0], p1, 0, 0, 0); }
}
__device__ __forceinline__ int v_st(int k, int c) { const int kk = (k & ~0xC) | ((k & 4) << 1) | ((k & 8) >> 1); return ((kk >> 3) * 4 + (c >> 5)) * 512 + ((kk & 7) * 32 + (c & 31)) * 2; }
__device__ __forceinline__ int v_rd_base(int lane) { return ((lane & 3) << 3) | (((lane >> 2) & 3) << 6) | (((lane >> 4) & 1) << 5) | (((lane >> 5) & 1) << 8); }
constexpr int v_rd_off(int d0, int ks, int half) { return d0 * 512 + ks * 4096 + half * 2048; }
template <int OFF> __device__ __forceinline__ s16x4 tr_read(int vb) {
  s16x4 r; asm volatile("ds_read_b64_tr_b16 %0, %1 offset:%2" : "=&v"(r) : "v"(vb), "i"(OFF) : "memory"); return r;
}
template <int D0> __device__ __forceinline__ void pv_one(f32x16& od, int vb, bf16x8 pa0, bf16x8 pa1, bf16x8 pa2, bf16x8 pa3) {
  const s16x4 l0 = tr_read<v_rd_off(D0, 0, 0)>(vb), h0 = tr_read<v_rd_off(D0, 0, 1)>(vb), l1 = tr_read<v_rd_off(D0, 1, 0)>(vb), h1 = tr_read<v_rd_off(D0, 1, 1)>(vb);
  const s16x4 l2 = tr_read<v_rd_off(D0, 2, 0)>(vb), h2 = tr_read<v_rd_off(D0, 2, 1)>(vb), l3 = tr_read<v_rd_off(D0, 3, 0)>(vb), h3 = tr_read<v_rd_off(D0, 3, 1)>(vb);
  asm volatile("s_waitcnt lgkmcnt(0)" ::: "memory"); SBAR();
#define PK(L, H) (bf16x8){L[0], L[1], L[2], L[3], H[0], H[1], H[2], H[3]}
  od = __builtin_amdgcn_mfma_f32_32x32x16_bf16(pa0, PK(l0, h0), od, 0, 0, 0);
  od = __builtin_amdgcn_mfma_f32_32x32x16_bf16(pa1, PK(l1, h1), od, 0, 0, 0);
  od = __builtin_amdgcn_mfma_f32_32x32x16_bf16(pa2, PK(l2, h2), od, 0, 0, 0);
  od = __builtin_amdgcn_mfma_f32_32x32x16_bf16(pa3, PK(l3, h3), od, 0, 0, 0);
#undef PK
}
__device__ __forceinline__ void pv_d0(f32x16* o, int vb, bf16x8 pa0, bf16x8 pa1, bf16x8 pa2, bf16x8 pa3) {
  pv_one<0>(o[0], vb, pa0, pa1, pa2, pa3); pv_one<1>(o[1], vb, pa0, pa1, pa2, pa3); pv_one<2>(o[2], vb, pa0, pa1, pa2, pa3); pv_one<3>(o[3], vb, pa0, pa1, pa2, pa3);
}

__device__ __forceinline__ void attn_dense_body(const bf16* __restrict__ Qb, const bf16* __restrict__ Kh, const bf16* __restrict__ Vh,
                                                bf16* __restrict__ Ob, int seq, char* lds, const int tid, const float mnC) {
  const int wid = tid >> 6, lane = tid & 63, r32 = lane & 31, hi = lane >> 5;
  bf16* V_lds = (bf16*)lds; bf16* K_lds = (bf16*)(lds + 2 * SHM_V);
  float* ws = (float*)(lds + 2 * SHM_V + 2 * SHM_K) + wid * 64; float* li_l = ws;
  float l_reg = 0; f32x16 o[4] = {}; bf16x8 qr[8];
  const bf16* Qw = Qb + (long)(wid * QBLK + r32) * LDQ + hi * 8;
#pragma unroll
  for (int d0 = 0; d0 < 8; ++d0) qr[d0] = ld8(Qw + d0 * 16);
  const int sr = tid >> 4, sc = (tid & 15) * 8, vst0 = v_st(sr, sc), vst1 = v_st(32 + sr, sc);
  const int vb0 = (int)(uintptr_t)V_lds + v_rd_base(lane);
  bf16x8 s0_vs0, s0_vs1, s0_ks0, s0_ks1;
#define SLOAD0(k0) do { s0_vs0 = ld8(&Vh[(long)((k0) + sr) * LDK + sc]); s0_vs1 = ld8(&Vh[(long)((k0) + 32 + sr) * LDK + sc]); \
    s0_ks0 = ld8(&Kh[(long)((k0) + sr) * LDK + sc]); s0_ks1 = ld8(&Kh[(long)((k0) + 32 + sr) * LDK + sc]); } while (0)
#define SWRITE0(b) do { *(bf16x8*)((char*)V_lds + (b) * SHM_V + vst0) = s0_vs0; *(bf16x8*)((char*)V_lds + (b) * SHM_V + vst1) = s0_vs1; const int kc = sc * 2; \
    *(bf16x8*)((char*)K_lds + (b) * SHM_K + KSWZ(sr, kc)) = s0_ks0; *(bf16x8*)((char*)K_lds + (b) * SHM_K + KSWZ(32 + sr, kc)) = s0_ks1; } while (0)
#define SWAIT() asm volatile("s_waitcnt vmcnt(0)" ::: "memory")
  f32x16 pA0, pA1, pB0, pB1; bf16x8 pa0, pa1, pa2, pa3; const int NT = seq / KVBLK;
  SLOAD0(0);
  bf16x8 t1_vs0 = ld8(&Vh[(long)(KVBLK + sr) * LDK + sc]), t1_vs1 = ld8(&Vh[(long)(KVBLK + 32 + sr) * LDK + sc]);
  bf16x8 t1_ks0 = ld8(&Kh[(long)(KVBLK + sr) * LDK + sc]), t1_ks1 = ld8(&Kh[(long)(KVBLK + 32 + sr) * LDK + sc]);
  asm volatile("s_waitcnt vmcnt(4)" ::: "memory"); SWRITE0(0); __syncthreads();
  qkt(pA0, pA1, K_lds, qr, r32, hi); partialSM(pA0, pA1, mnC);
  s0_vs0 = t1_vs0; s0_vs1 = t1_vs1; s0_ks0 = t1_ks0; s0_ks1 = t1_ks1;
  SWAIT(); SWRITE0(1); __syncthreads();
  if (__builtin_amdgcn_readfirstlane(wid) >= 4) __builtin_amdgcn_s_setprio(1);
  for (int j = 1; j + 1 < NT; j += 2) {
    SBAR(); qkt(pB0, pB1, (bf16*)((char*)K_lds + SHM_K), qr, r32, hi);
    finishSM(pA0, pA1, l_reg, pa0, pa1, pa2, pa3); SBAR();
    SLOAD0((j + 1) * KVBLK); SBAR();
    pv_d0(o, vb0, pa0, pa1, pa2, pa3); partialSM(pB0, pB1, mnC);
    __syncthreads(); SWAIT(); SWRITE0(0);
    SBAR(); __syncthreads();
    SBAR(); qkt(pA0, pA1, K_lds, qr, r32, hi);
    finishSM(pB0, pB1, l_reg, pa0, pa1, pa2, pa3); SBAR();
    SLOAD0((j + 2) * KVBLK); SBAR();
    pv_d0(o, vb0 + (int)SHM_V, pa0, pa1, pa2, pa3); partialSM(pA0, pA1, mnC);
    __syncthreads(); SWAIT(); SWRITE0(1);
    SBAR(); __syncthreads();
  }
  SBAR(); qkt(pB0, pB1, (bf16*)((char*)K_lds + SHM_K), qr, r32, hi);
  finishSM(pA0, pA1, l_reg, pa0, pa1, pa2, pa3); SBAR();
  pv_d0(o, vb0, pa0, pa1, pa2, pa3); partialSM(pB0, pB1, mnC);
  __syncthreads();
  finishSM(pB0, pB1, l_reg, pa0, pa1, pa2, pa3); SBAR();
  pv_d0(o, vb0 + (int)SHM_V, pa0, pa1, pa2, pa3);
  { auto rr = __builtin_amdgcn_permlane32_swap(__float_as_uint(l_reg), __float_as_uint(l_reg), false, false);
    l_reg = __uint_as_float(rr[0]) + __uint_as_float(rr[1]); }
  __builtin_amdgcn_s_setprio(0);
  if (hi == 0) li_l[r32] = l_reg; asm volatile("s_waitcnt lgkmcnt(0)" ::: "memory");
  float rli[16];
#pragma unroll
  for (int r = 0; r < 16; ++r) rli[r] = __builtin_amdgcn_rcpf(li_l[crow(r, hi)]);
  bf16* Ow = Ob + (long)(wid * QBLK) * LDO;
#pragma unroll
  for (int r = 0; r < 16; ++r) { const int orow = crow(r, hi);
#pragma unroll
    for (int d0 = 0; d0 < 4; ++d0) Ow[(long)orow * LDO + d0 * 32 + r32] = __float2bfloat16(o[d0][r] * rli[r]); }
  __syncthreads();
#undef SLOAD0
#undef SWRITE0
#undef SWAIT
}
}

#define LAS __attribute__((address_space(3)))
typedef unsigned short bf16;
typedef float f32x4 __attribute__((ext_vector_type(4)));
typedef float f32x2 __attribute__((ext_vector_type(2)));
typedef unsigned v4u __attribute__((ext_vector_type(4)));
typedef unsigned v2u __attribute__((ext_vector_type(2)));
typedef short s16x8 __attribute__((ext_vector_type(8)));

constexpr int NWAVES = 8;
constexpr int LDS_BYTES = 147456;
constexpr size_t MiB = 1u << 20;
constexpr size_t WS_MOD  = 0;
constexpr size_t WS_W1   = 1 * MiB;
constexpr size_t WS_W2   = WS_W1 + 32 * MiB;
constexpr size_t WS_WIN  = WS_W2 + 32 * MiB;
constexpr size_t WS_WQKV = WS_WIN + 8 * MiB;
constexpr size_t WS_WO   = WS_WQKV + 4 * MiB;
constexpr size_t WS_WOUT = WS_WO + 2 * MiB;
constexpr size_t WS_WP   = WS_WOUT + 4 * MiB;
constexpr size_t WS_WS   = WS_WP + 1 * MiB;
constexpr size_t WS_HCTX = WS_WS + 1 * MiB;
constexpr size_t WS_A    = WS_HCTX + 2 * MiB;
constexpr size_t WS_F    = WS_A + 33 * MiB;
constexpr size_t WS_G    = WS_F + 132 * MiB;
constexpr size_t WS_ST   = WS_G + 64 * MiB;
constexpr size_t WS_SSQ  = WS_ST + 4 * MiB;
constexpr size_t WS_H16  = WS_SSQ + 2 * MiB;
constexpr size_t WS_END  = WS_H16 + 33 * MiB;
constexpr size_t WS_BIAS = 512 * 1024;
constexpr size_t WS_BAR  = 896 * 1024;
constexpr int LDS_BARST = LDS_BYTES - 64;
constexpr size_t F_Q = 66 * MiB, F_K = F_Q + 32 * MiB, F_V = F_K + 17 * MiB;
static_assert(F_V + 17 * MiB <= 132 * MiB, "Q|K|V inside F");

struct Args {
    const float *x, *c, *ctx, *c_ctx, *ada_w, *ada_b, *norm_g, *mlp_w1, *mlp_w2, *pool_w, *pool_scale, *attn_w_qkv, *attn_w_o, *attn_q_g, *attn_k_g,
                *gm_w_in, *gm_ln_g, *gm_ln_b, *gm_ws, *gm_bs, *gm_w_out, *final_g;
    float* out; unsigned char* ws; int ph_lo, ph_hi;
};

__device__ __forceinline__ unsigned f2bf(float f) { unsigned u = __builtin_bit_cast(unsigned, f); return (u + 0x7fffu + ((u >> 16) & 1u)) >> 16; }
__device__ __forceinline__ unsigned pk2(float lo, float hi) { return pg8::cvt_pk_bf16(lo, hi); }
__device__ __forceinline__ float bf_lo(unsigned w) { return __uint_as_float(w << 16); }
__device__ __forceinline__ float bf_hi(unsigned w) { return __uint_as_float(w & 0xffff0000u); }
__device__ __forceinline__ float wave_sum(float v) {
#pragma unroll
    for (int o = 1; o < 64; o <<= 1) v += __shfl_xor(v, o);
    return v;
}
__device__ __forceinline__ const float* rowp(const float* lat, const float* ctx, int row) { return row < MLAT ? lat + (size_t)row * DM : ctx + (size_t)(row - MLAT) * DM; }
__device__ __forceinline__ int bidx(int row) { return row >= MLAT ? 2 : (row >> 13); }


#define XB_TMO      128
#define XB_XCNT(j)  (256  + 64 * (j))
#define XB_XSUB(j)  (1280 + 64 * (j))
#define XB_XGEN(j)  (2304 + 64 * (j))
#define XB_TOP      3328
#define XB_TOPGEN   3392
#define XCD_BAR_WORDS 3456
#define XB_SPIN_CAP (1u << 18)
__device__ __forceinline__ unsigned xb_ld(unsigned* p)              { return __hip_atomic_load(p, __ATOMIC_RELAXED, __HIP_MEMORY_SCOPE_AGENT); }
__device__ __forceinline__ unsigned xb_add(unsigned* p, unsigned v) { return __hip_atomic_fetch_add(p, v, __ATOMIC_RELAXED, __HIP_MEMORY_SCOPE_AGENT); }
__device__ __forceinline__ unsigned xb_xcc_id() { return (unsigned)__builtin_amdgcn_s_getreg((3 << 11) | 20) & 0xFu; }
#define XB_SPIN(cond, bar) do { unsigned _sp = 0; while (cond) { __builtin_amdgcn_s_sleep(1); \
    if ((++_sp & 255u) == 0u) { if (xb_ld(&(bar)[XB_TMO])) break; if (_sp > XB_SPIN_CAP) { atomicAdd(&(bar)[XB_TMO], 1u); break; } } } } while (0)
struct XcdBarrier { unsigned* bar; unsigned x; volatile LAS unsigned* st; };
__device__ __forceinline__ XcdBarrier xcd_barrier_post(unsigned* bar, volatile LAS unsigned* st, int tid) {
    XcdBarrier b; b.bar = bar; b.x = xb_xcc_id(); b.st = st;
    if (tid == 0) (void)xb_add(&bar[XB_XCNT(b.x)], 1u);
    return b;
}
__device__ __forceinline__ void xcd_barrier_complete(unsigned* bar, unsigned x, unsigned& nloc, unsigned& nx) {
    const unsigned G = gridDim.x * gridDim.y * gridDim.z;
    unsigned sum, cnt, mine, sp = 0u;
    for (;;) {
        sum = 0u; cnt = 0u; mine = 0u;
#pragma unroll
        for (unsigned j = 0; j < 16; ++j) { const unsigned c = xb_ld(&bar[XB_XCNT(j)]); sum += c; cnt += (c > 0u) ? 1u : 0u; mine = (j == x) ? c : mine; }
        if (sum == G) break;
        __builtin_amdgcn_s_sleep(1);
        if ((++sp & 255u) == 0u) { if (xb_ld(&bar[XB_TMO])) break; if (sp > XB_SPIN_CAP) { atomicAdd(&bar[XB_TMO], 1u); break; } }
    }
    nloc = mine > 0u ? mine : 1u; nx = cnt > 0u ? cnt : 1u;
}
__device__ __forceinline__ void xcd_barrier(const XcdBarrier& b, int tid) {
    asm volatile("s_waitcnt vmcnt(0)" ::: "memory");
    __syncthreads();
    if (tid == 0) {
        unsigned* bar = b.bar;
        __builtin_amdgcn_s_waitcnt(0);
        unsigned nloc = b.st[0], nx = b.st[1];
        if (nloc == 0u) { xcd_barrier_complete(bar, b.x, nloc, nx); b.st[0] = nloc; b.st[1] = nx; }
        const unsigned old = xb_add(&bar[XB_XSUB(b.x)], 1u);
        const unsigned gen = old / nloc;
        if (old + 1u == (gen + 1u) * nloc) {
            __builtin_amdgcn_fence(__ATOMIC_RELEASE, "agent");
            asm volatile("s_waitcnt vmcnt(0)" ::: "memory");
            const unsigned og = xb_add(&bar[XB_TOP], 1u);
            const unsigned tg = og / nx;
            if (og + 1u == (tg + 1u) * nx) xb_add(&bar[XB_TOPGEN], 1u);
            else XB_SPIN(xb_ld(&bar[XB_TOPGEN]) == tg, bar);
            __builtin_amdgcn_fence(__ATOMIC_ACQUIRE, "agent");
            xb_add(&bar[XB_XGEN(b.x)], 1u);
            asm volatile("s_waitcnt vmcnt(0)" ::: "memory");
        } else {
            XB_SPIN(xb_ld(&bar[XB_XGEN(b.x)]) == gen, bar);
            __builtin_amdgcn_fence(__ATOMIC_ACQUIRE, "agent");
            asm volatile("s_waitcnt vmcnt(0)" ::: "memory");
        }
    }
    __syncthreads();
}

struct TrD { const float* W; bf16* WT; int K, N, item, perm; };
__device__ __forceinline__ void tr_load(const TrD& d, int lane, f32x4 (&v)[16]) {
    const int nblk = d.N / 64, kb = d.item / nblk, nb = d.item % nblk, k0 = 64 * kb, n0 = 64 * nb, lr = lane >> 4, lc = (lane & 15) * 4;
    const float* src = d.W + (size_t)(k0 + lr) * d.N + n0 + lc;
#pragma unroll
    for (int i = 0; i < 16; ++i) v[i] = __builtin_nontemporal_load((const f32x4*)(src + (size_t)(4 * i) * d.N));
}
__device__ __forceinline__ void tr_lds_write(LAS float* scr, int lane, const f32x4 (&v)[16]) {
    const int lr = lane >> 4, lc = (lane & 15) * 4;
#pragma unroll
    for (int i = 0; i < 16; ++i) { const int kk = 4 * i + lr; scr[kk * 65 + lc + 0] = v[i][0]; scr[kk * 65 + lc + 1] = v[i][1]; scr[kk * 65 + lc + 2] = v[i][2]; scr[kk * 65 + lc + 3] = v[i][3]; }
    asm volatile("s_waitcnt lgkmcnt(0)" ::: "memory");
}
__device__ __forceinline__ void tr_store(const TrD& d, LAS float* scr, int lane) {
    const int nblk = d.N / 64, kb = d.item / nblk, nb = d.item % nblk, k0 = 64 * kb, n0 = 64 * nb, c = lane & 7;
#pragma unroll
    for (int j = 0; j < 8; ++j) { const int n = (lane >> 3) + 8 * j; const LAS float* s = scr + (8 * c) * 65 + n;
        v4u o; o.x = pk2(s[0 * 65], s[1 * 65]); o.y = pk2(s[2 * 65], s[3 * 65]); o.z = pk2(s[4 * 65], s[5 * 65]); o.w = pk2(s[6 * 65], s[7 * 65]);
        int dn = n0 + n; if (d.perm && dn < 1536) { const int f = dn & 127; dn = (dn & ~127) | ((f >> 6) * 64 + 2 * (f & 31) + ((f >> 5) & 1)); }
        __builtin_nontemporal_store(o, (v4u*)(d.WT + (size_t)dn * d.K + k0 + 8 * c)); }
    asm volatile("s_waitcnt lgkmcnt(0)" ::: "memory");
}
__device__ __forceinline__ void norm_phase(const float* hl, const float* hc, int nrows, const float* ng, const float* modl  , int which_shift, bf16* out, int gw, int NGW, int lane) {
    f32x4 g4[4];
#pragma unroll
    for (int j = 0; j < 4; ++j) g4[j] = *(const f32x4*)(ng + 4 * lane + 256 * j);
    for (int row = gw; row < nrows; row += NGW) {
        const f32x4* xr = (const f32x4*)rowp(hl, hc, row) + lane;
        const float* mp = modl + bidx(row) * 6144 + which_shift * 1024;
        f32x4 v[4]; float ss = 0.f;
#pragma unroll
        for (int j = 0; j < 4; ++j) { v[j] = xr[64 * j]; ss += (v[j][0] * v[j][0] + v[j][1] * v[j][1]) + (v[j][2] * v[j][2] + v[j][3] * v[j][3]); }
        const float rstd = rsqrtf(wave_sum(ss) * (1.f / DM) + EPS);
        unsigned long long* o8 = (unsigned long long*)(out + (size_t)row * DM) + lane;
#pragma unroll
        for (int j = 0; j < 4; ++j) { const f32x4 sh = *(const f32x4*)(mp + 4 * lane + 256 * j), sc = *(const f32x4*)(mp + 1024 + 4 * lane + 256 * j);
            const f32x4 y = (v[j] * rstd * g4[j]) * (sc + 1.0f) + sh;
            o8[64 * j] = (unsigned long long)pk2(y[0], y[1]) | ((unsigned long long)pk2(y[2], y[3]) << 32); }
    }
}

__global__ void __launch_bounds__(NWAVES * 64, 2) fwd_kernel(Args args) {
    extern __shared__ __attribute__((aligned(16))) unsigned char lds[];
    cg::grid_group grid = cg::this_grid();
    LAS unsigned char* L = (LAS unsigned char*)lds;
    const int tid0 = threadIdx.x;
    const int G0 = gridDim.x, bx0 = blockIdx.x;
    typedef const __attribute__((address_space(4))) Args* ArgP;
    const ArgP argp = (ArgP)__builtin_amdgcn_kernarg_segment_ptr();
    ArgP A_ = argp;
#define WSP(T, off) ((T*)(A_->ws + (off)))
#define MOD   WSP(float, WS_MOD)
#define W1T   WSP(bf16, WS_W1)
#define W2T   WSP(bf16, WS_W2)
#define WINT  WSP(bf16, WS_WIN)
#define WQKVT WSP(bf16, WS_WQKV)
#define WOT   WSP(bf16, WS_WO)
#define WOUTT WSP(bf16, WS_WOUT)
#define WPT   WSP(bf16, WS_WP)
#define WSB   WSP(bf16, WS_WS)
#define CACC  WSP(float, WS_G)
#define H16   WSP(bf16, WS_H16)
#define AB    WSP(bf16, WS_A)
#define FB    WSP(bf16, WS_F)
#define GB    WSP(bf16, WS_G)
#define ST    WSP(float, WS_ST)
#define QB    WSP(bf16, WS_F + F_Q)
#define KB    WSP(bf16, WS_F + F_K)
#define VB    WSP(bf16, WS_F + F_V)
#define BI_W1  WSP(float, WS_BIAS)
#define BI_QKV WSP(float, WS_BIAS + 4 * 3 * 4096 * 4)
#define BI_WIN WSP(float, WS_BIAS + 4 * 3 * 4096 * 4 + 3 * 2048 * 4)
#define SSQ    WSP(float, WS_SSQ)
    const int lo = args.ph_lo, hi = args.ph_hi;
    int ph = 0;
    if (tid0 < 2) ((volatile LAS unsigned*)(L + LDS_BARST))[tid0] = 0u;
    __syncthreads();
    XcdBarrier xbar = xcd_barrier_post((unsigned*)(A_->ws + WS_BAR), (volatile LAS unsigned*)(L + LDS_BARST), tid0);
#define PHASE_BEGIN_C(cls) if (lo <= ph && ph < hi) { for (int rep_ = 0; rep_ <= ((PROBE_MASK >> (cls)) & 1); ++rep_) { int tid = tid0; asm volatile("" : "+v"(tid)); const int lane = tid & 63, wave = __builtin_amdgcn_readfirstlane(tid >> 6); int bx = bx0, G = G0; asm volatile("" : "+s"(bx), "+s"(G)); const int gw = bx * NWAVES + wave, NGW = G * NWAVES; (void)lane; (void)gw; (void)NGW; ArgP A_ = argp; asm volatile("" : "+s"(A_));
#define PHASE_BEGIN PHASE_BEGIN_C(31)
#define PHASE_END   } if (ph + 1 < hi) { if (lo < 0) grid.sync(); int tb_ = tid0; asm volatile("" : "+v"(tb_)); xcd_barrier(xbar, tb_); if ((PROBE_MASK >> 8) & 1) xcd_barrier(xbar, tb_); } } ++ph;

    constexpr int I_W = 1024, I_QKV = 512, I_O = 256, I_OUT = 512, I_P = 16;
#define TR_DECODE(r_, D) do { int r = (r_); \
            if (r < 4 * I_W) { const int l = r / I_W; D = TrD{A_->mlp_w1 + (size_t)l * DM * DFF, W1T + (size_t)l * DM * DFF, DM, DFF, r % I_W, 0}; break; } r -= 4 * I_W; \
            if (r < 4 * I_W) { const int l = r / I_W; D = TrD{A_->mlp_w2 + (size_t)l * DM * DFF, W2T + (size_t)l * DM * DFF, DFF, DM, r % I_W, 0}; break; } r -= 4 * I_W; \
            if (r < I_W) { D = TrD{A_->gm_w_in, WINT, DM, 4096, r, 0}; break; } r -= I_W; \
            if (r < I_QKV) { D = TrD{A_->attn_w_qkv, WQKVT, DM, 2048, r, 1}; break; } r -= I_QKV; \
            if (r < I_O) { D = TrD{A_->attn_w_o, WOT, DM, DM, r, 0}; break; } r -= I_O; \
            if (r < I_OUT) { D = TrD{A_->gm_w_out, WOUTT, 2048, DM, r, 0}; break; } r -= I_OUT; \
            { const int m = r / I_P; D = TrD{A_->pool_w + (size_t)m * 65536, WPT + (size_t)m * 65536, 256, 256, r % I_P, 0}; } } while (0)
#define TR_SETMAP(SET, j) ((SET) == 0 ? ((j) < 1024 ? (j) : 10496 + ((j) - 1024)) : \
                           (SET) == 1 ? ((j) < 512 ? 9216 + (j) : 9728 + ((j) - 512)) : \
                           (SET) == 2 ? ((j) < 1024 ? 1024 + (j) : ((j) < 2048 ? 5120 + ((j) - 1024) : ((j) < 3072 ? 8192 + ((j) - 2048) : 4096 + ((j) - 3072)))) : \
                           (SET) == 3 ? ((j) < 512 ? 9984 + (j) : ((j) < 1536 ? 2048 + ((j) - 512) : ((j) < 2560 ? 6144 + ((j) - 1536) : 3072 + ((j) - 2560)))) : \
                                        7168 + (j))
#define TR_RUN(SET, NSET, IW, NW) do { TrD d, dn; f32x4 v[16]; const int iw_ = (IW), nw_ = (NW); \
        { const int j0_ = iw_ < (NSET) ? iw_ : 0; TR_DECODE(TR_SETMAP(SET, j0_), d); } tr_load(d, lane, v); \
        for (int j = iw_; j < (NSET); j += nw_) { tr_lds_write(scr, lane, v); \
            { const int jn_ = j + nw_ < (NSET) ? j + nw_ : j; TR_DECODE(TR_SETMAP(SET, jn_), dn); } tr_load(dn, lane, v); \
            tr_store(d, scr, lane); d = dn; } } while (0)
#define BIAS_RUN(LO, HI, IW, NW) do { const int iw_ = (IW), nw_ = (NW), ntrip = ((HI) - (LO) + nw_ - 1) / nw_; \
        for (int i0 = 0; i0 < ntrip; i0 += 4) { float sb[4][3]; float* outp[4]; int nbv[4]; bool okv[4]; \
            _Pragma("unroll") for (int k = 0; k < 4; ++k) { int r = (LO) + iw_ + (i0 + k) * nw_; const bool ok = (i0 + k) < ntrip && r < (HI); r = ok ? r : (LO); okv[k] = ok; \
                const int mid = r < 16384 ? (r >> 12) : (r < 18432 ? 4 : 5), n = r < 16384 ? (r & 4095) : (r < 18432 ? r - 16384 : r - 18432); \
                const size_t woff = mid < 4 ? WS_W1 + ((size_t)mid * 4096 + n) * 2048 : (mid == 4 ? WS_WQKV + (size_t)n * 2048 : WS_WIN + (size_t)n * 2048); \
                const int ml = mid < 4 ? mid : mid - 3, which = mid < 4 ? 3 : 0; nbv[k] = mid == 4 ? 2048 : 4096; \
                const size_t ooff = mid < 4 ? (size_t)mid * 3 * 4096 : (mid == 4 ? (size_t)4 * 3 * 4096 : (size_t)4 * 3 * 4096 + 3 * 2048); \
                const bf16* wrow = (const bf16*)(A_->ws + woff); const float* shp = MOD + (size_t)ml * 3 * 6144 + which * 1024; outp[k] = BI_W1 + ooff + n; \
                const v4u w0 = *(const v4u*)(wrow + 16 * lane), w1 = *(const v4u*)(wrow + 16 * lane + 8); \
                const f32x4 wf0 = {bf_lo(w0.x), bf_hi(w0.x), bf_lo(w0.y), bf_hi(w0.y)}, wf1 = {bf_lo(w0.z), bf_hi(w0.z), bf_lo(w0.w), bf_hi(w0.w)}; \
                const f32x4 wf2 = {bf_lo(w1.x), bf_hi(w1.x), bf_lo(w1.y), bf_hi(w1.y)}, wf3 = {bf_lo(w1.z), bf_hi(w1.z), bf_lo(w1.w), bf_hi(w1.w)}; \
                _Pragma("unroll") for (int b = 0; b < 3; ++b) { const f32x4* sp = (const f32x4*)(shp + b * 6144 + 16 * lane); \
                    const f32x4 a4 = (wf0 * sp[0] + wf1 * sp[1]) + (wf2 * sp[2] + wf3 * sp[3]); sb[k][b] = (a4[0] + a4[1]) + (a4[2] + a4[3]); } } \
            _Pragma("unroll") for (int o = 1; o < 64; o <<= 1) _Pragma("unroll") for (int k = 0; k < 4; ++k) { sb[k][0] += __shfl_xor(sb[k][0], o); sb[k][1] += __shfl_xor(sb[k][1], o); sb[k][2] += __shfl_xor(sb[k][2], o); } \
            _Pragma("unroll") for (int k = 0; k < 4; ++k) if (okv[k] && lane == 0) { outp[k][0] = sb[k][0]; outp[k][nbv[k]] = sb[k][1]; outp[k][2 * (size_t)nbv[k]] = sb[k][2]; } } } while (0)
#define TAIL_FIRST(NWG) ((NWG) % G)

    PHASE_BEGIN_C(0)
    {
        LAS float* sl = (LAS float*)L;
        LAS float* red = (LAS float*)(L + 12288);
        if (bx < 192) {
            for (int i = tid; i < 3 * 1024; i += 512) { const float cv = i < 2048 ? A_->c[i] : A_->c_ctx[i - 2048]; sl[i] = cv / (1.0f + __expf(-cv)); }
            __syncthreads();
            for (int it = bx; it < 192; it += G) {
                const int layer = it / 48, n0 = (it % 48) * 128, half = lane >> 5, cq = lane & 31;
                const float* W = A_->ada_w + (size_t)layer * 1024 * 6144 + n0 + 4 * cq;
                f32x4 a0 = {0.f, 0.f, 0.f, 0.f}, a1 = a0, a2 = a0;
#pragma unroll 16
                for (int i = 0; i < 64; ++i) { const int k = wave * 128 + 2 * i + half; const f32x4 w = __builtin_nontemporal_load((const f32x4*)(W + (size_t)k * 6144));
                    a0 += w * sl[k]; a1 += w * sl[1024 + k]; a2 += w * sl[2048 + k]; }
                const int slot = wave * 2 + half;
#pragma unroll
                for (int e = 0; e < 4; ++e) { red[(slot * 3 + 0) * 128 + 4 * cq + e] = a0[e]; red[(slot * 3 + 1) * 128 + 4 * cq + e] = a1[e]; red[(slot * 3 + 2) * 128 + 4 * cq + e] = a2[e]; }
                __syncthreads();
                if (tid < 384) { const int b = tid >> 7, col = tid & 127; float s = 0.f;
#pragma unroll
                    for (int k = 0; k < 16; ++k) s += red[(k * 3 + b) * 128 + col];
                    MOD[(size_t)(layer * 3 + b) * 6144 + n0 + col] = s + A_->ada_b[layer * 6144 + n0 + col]; }
                __syncthreads();
            }
        }
        __syncthreads();
        {
          const bool split_ = G > 192; const int iw0_ = split_ ? (bx - 192) * NWAVES + wave : gw, nw0_ = split_ ? (G - 192) * NWAVES : NGW;
          if (!split_ || bx >= 192) { LAS float* scr = (LAS float*)(L + wave * 16640); TR_RUN(0, 1152, iw0_, nw0_); } }
        for (int row = gw; row < MALL; row += 2 * NGW) { const int rowb = row + NGW < MALL ? row + NGW : row;
            const f32x4* xa = (const f32x4*)rowp(A_->x, A_->ctx, row) + lane; const f32x4* xb = (const f32x4*)rowp(A_->x, A_->ctx, rowb) + lane; f32x4 va[4], vb[4];
#pragma unroll
            for (int j = 0; j < 4; ++j) { va[j] = xa[64 * j]; vb[j] = xb[64 * j]; }
            float sa = 0.f, sb = 0.f;
#pragma unroll
            for (int j = 0; j < 4; ++j) { sa += (va[j][0] * va[j][0] + va[j][1] * va[j][1]) + (va[j][2] * va[j][2] + va[j][3] * va[j][3]); sb += (vb[j][0] * vb[j][0] + vb[j][1] * vb[j][1]) + (vb[j][2] * vb[j][2] + vb[j][3] * vb[j][3]); }
#pragma unroll
            for (int o = 1; o < 64; o <<= 1) { sa += __shfl_xor(sa, o); sb += __shfl_xor(sb, o); }
            if (lane < 16) { SSQ[(size_t)row * 16 + lane] = lane == 0 ? sa : 0.f; SSQ[(size_t)rowb * 16 + lane] = lane == 0 ? sb : 0.f; } }
        for (int i = bx * 512 + tid; i < 8 * 128 * 128 / 4; i += G * 512) { const f32x4 v = *(const f32x4*)(A_->gm_ws + 4 * (size_t)i);
            *(v2u*)(WSB + 4 * (size_t)i) = (v2u){pk2(v[0], v[1]), pk2(v[2], v[3])}; }
        __syncthreads();
    }
    PHASE_END

#pragma unroll 1
    for (int layer = 0; layer < DEPTH; ++layer) {
#define kind   (layer % 3)
#define jl     (layer / 3)
#define modl   (MOD + (size_t)layer * 3 * 6144)
#define ng0    (A_->norm_g + (size_t)layer * 2 * DM)
#define ng1    (ng0 + DM)
#define nrows  (layer == 0 ? MALL : MLAT)
#define src_l  (A_->x)
#define src_c  (A_->ctx)
#define next_hb ((layer + 1 < DEPTH) && ((layer + 1) % 3 != 0))

        if (kind == 0) {
            PHASE_BEGIN_C(layer == 0 ? 1 : 13)
            {
                LAS float* rs = (LAS float*)L;
                LAS f32x4* tile = (LAS f32x4*)(L + 512);
                const int nitems = (nrows / 64) * 4;
                f32x4 pv[10]; float rreg;
#define PL_DECODE(it_, g_, t0_, ss_, Ls_, b_) const int g_ = (it_) & 3, t0_ = ((it_) >> 2) * 64; int ss_, Ls_, b_; \
        if (t0_ < MLAT) { ss_ = t0_ & ~(SEQ - 1); Ls_ = SEQ; b_ = t0_ >> 13; } else { ss_ = MLAT + ((t0_ - MLAT) & ~(CTXL - 1)); Ls_ = CTXL; b_ = 2; }
#define PL_PREFETCH(it_) do { PL_DECODE(it_, gp_, t0p_, ssp_, Lsp_, bp_) (void)bp_; const int T0p_ = t0p_ - ssp_; \
        _Pragma("unroll") for (int k = 0; k < 10; ++k) { const int i = tid + 512 * k, pos = T0p_ - 8 + (i >> 6); int pc = pos < 0 ? 0 : (pos >= Lsp_ ? Lsp_ - 1 : pos); \
            f32x4 v; if (layer == 0) v = *(const f32x4*)(rowp(src_l, src_c, ssp_ + pc) + 256 * gp_ + 4 * (i & 63)); \
            else { const v2u r_ = *(const v2u*)(H16 + (size_t)(ssp_ + pc) * DM + 256 * gp_ + 4 * (i & 63)); v = (f32x4){bf_lo(r_.x), bf_hi(r_.x), bf_lo(r_.y), bf_hi(r_.y)}; } \
            if (pc != pos) v = (f32x4){0.f, 0.f, 0.f, 0.f}; pv[k] = v; } \
        { const int pos = T0p_ - 8 + (tid < 80 ? tid : 0); const int pc = pos < 0 ? 0 : (pos >= Lsp_ ? Lsp_ - 1 : pos); \
          const f32x4* sp = (const f32x4*)(SSQ + (size_t)(ssp_ + pc) * 16); const f32x4 t4 = (sp[0] + sp[1]) + (sp[2] + sp[3]); \
          rreg = pc == pos ? rsqrtf(((t4[0] + t4[1]) + (t4[2] + t4[3])) * (1.f / DM) + EPS) : 0.f; } } while (0)
                { const int it0_ = bx < nitems ? bx : 0; PL_PREFETCH(it0_); }
                for (int it = bx; it < nitems; it += G) {
                    PL_DECODE(it, g, t0, seq_start, Ls, b) const int hw = 1 << g, T0 = t0 - seq_start;
                    if (tid < 80) rs[tid] = rreg;
#pragma unroll
                    for (int k = 0; k < 10; ++k) tile[tid + 512 * k] = pv[k];
                    __syncthreads();
                    { const int itn_ = it + G < nitems ? it + G : it; PL_PREFETCH(itn_); }
                    { const int q = tid & 63, rg = tid >> 6, lb = rg * 8 + 8; const float* mp = modl + b * 6144;
                      const f32x4 cA = *(const f32x4*)(ng0 + 256 * g + 4 * q) * (*(const f32x4*)(mp + 1024 + 256 * g + 4 * q) + 1.0f);
#define TV(i_) (tile[(i_) * 64 + q] * rs[(i_)])
                      f32x4 S = TV(lb - hw);
                      if (g == 0) { S += TV(lb); }
                      else if (g == 1) {
#pragma unroll
                          for (int i = 1; i < 4; ++i) S += TV(lb - 2 + i); }
                      else if (g == 2) {
#pragma unroll
                          for (int i = 1; i < 8; ++i) S += TV(lb - 4 + i); }
                      else {
#pragma unroll
                          for (int i = 1; i < 16; ++i) S += TV(lb - 8 + i); }
#pragma unroll
                      for (int j = 0; j < 8; ++j) { const int pos = T0 + rg * 8 + j;
                          const int wlo = pos - hw < 0 ? 0 : pos - hw, whi = pos + hw > Ls ? Ls : pos + hw;
                          const f32x4 pvv = (S * (1.0f / (float)(whi - wlo)) - TV(lb + j)) * cA;
                          *(v2u*)(AB + (size_t)(seq_start + pos) * DM + 256 * g + 4 * q) = (v2u){pk2(pvv[0], pvv[1]), pk2(pvv[2], pvv[3])};
                          if (j < 7) S += TV(lb + j + hw) - TV(lb + j - hw); }
#undef TV
                    }
                    __syncthreads();
                }
#undef PL_PREFETCH
#undef PL_DECODE
                if (layer == 0) {
                }
            }
            PHASE_END
            PHASE_BEGIN
            {
                pg8::Gemm g{AB, WPT + (size_t)jl * 1024 * 256, nrows, DM, 256, DM, 512, 256}; pg8::StaticOrder S; S.init(nrows, DM, G, bx);
                pg8::EpiRes E{layer == 0 ? src_l : nullptr, layer == 0 ? src_c : nullptr, H16, modl + 2 * 1024, A_->pool_scale + (size_t)jl * DM, AB, ng1, modl + 4 * 1024, SSQ};
                pg8::gemm_phase<pg8::EpiRes, pg8::StaticOrder>(L, g, S, E, tid);
                if (layer == 0) { const int fi = TAIL_FIRST(nrows / 256 * 4);
                    if (bx >= fi) { LAS float* scr = (LAS float*)(L + wave * 16640); TR_RUN(1, 768, (bx - fi) * NWAVES + wave, (G - fi) * NWAVES);
                        BIAS_RUN(0, 4096, (bx - fi) * NWAVES + wave, (G - fi) * NWAVES); } }
            }
            PHASE_END
        } else if (kind == 1) {
            PHASE_BEGIN_C(6)
            {
                pg8::Gemm g{AB, WQKVT, MALL, 2048, DM, DM, 0, DM}; pg8::StaticOrder S; S.init(MALL, 2048, G, bx);
                pg8::EpiQKV E{QB, KB, VB, SSQ, BI_QKV, A_->attn_q_g + (size_t)jl * 128, A_->attn_k_g + (size_t)jl * 128, (LAS float*)(L + pg8::STAGE_BYTES)};
                pg8::gemm_phase<pg8::EpiQKV, pg8::StaticOrder>(L, g, S, E, tid);
                { const int fi = TAIL_FIRST(MALL / 256 * 8);
                  if (bx >= fi) { LAS float* scr = (LAS float*)(L + wave * 16640); TR_RUN(4, 1024, (bx - fi) * NWAVES + wave, (G - fi) * NWAVES);
                      BIAS_RUN(4096, 16384, (bx - fi) * NWAVES + wave, (G - fi) * NWAVES); BIAS_RUN(18432, 22528, (bx - fi) * NWAVES + wave, (G - fi) * NWAVES); } }
            }
            PHASE_END
            PHASE_BEGIN_C(3)
            {
                float mnC;
                { const float* qgp = A_->attn_q_g + (size_t)jl * 128; const float* kgp = A_->attn_k_g + (size_t)jl * 128;
                  float mq = fmaxf(fabsf(qgp[lane]), fabsf(qgp[64 + lane])), mk = fmaxf(fabsf(kgp[lane]), fabsf(kgp[64 + lane]));
#pragma unroll
                  for (int o = 1; o < 64; o <<= 1) { mq = fmaxf(mq, __shfl_xor(mq, o)); mk = fmaxf(mk, __shfl_xor(mk, o)); }
                  mnC = __builtin_bit_cast(float, __builtin_amdgcn_readfirstlane(__builtin_bit_cast(int, -(11.3138f * 1.01f * mq * mk + 0.05f) * 1.4426950408889634f))); }
                for (int idx = bx; idx < 512; idx += G) {
                    int tidu = tid; asm volatile("" : "+v"(tidu));
                    const int xcd = idx & 7, local = (idx >> 3) & 31, i2 = idx >> 8;
                    const int b = xcd >> 2, kvh = xcd & 3, h = kvh * 2 + i2, qblk = local;
                    const size_t qoff = ((size_t)(b * SEQ + qblk * 256)) * DM + h * 128;
                    const size_t koff = (size_t)b * SKV * 512 + kvh * 128;
                    attn::attn_dense_body((const attn::bf16*)QB + qoff, (const attn::bf16*)KB + koff, (const attn::bf16*)VB + koff, (attn::bf16*)GB + qoff, SKV, (char*)lds, tidu, mnC);
                }
            }
            PHASE_END
            PHASE_BEGIN
            {
                pg8::Gemm g{GB, WOT, MLAT, DM, DM, DM, 0, DM}; pg8::StaticOrder S; S.init(MLAT, DM, G, bx);
                pg8::EpiRes E{nullptr, nullptr, H16, modl + 2 * 1024, nullptr, AB, ng1, modl + 4 * 1024, SSQ};
                pg8::gemm_phase<pg8::EpiRes, pg8::StaticOrder>(L, g, S, E, tid);
            }
            PHASE_END
        } else {
            PHASE_BEGIN_C(6)
            {
                pg8::Gemm g{AB, WINT, MLAT, 4096, DM, DM, 0, DM}; pg8::StaticOrder S; S.init(MLAT, 4096, G, bx);
                pg8::EpiBf16<2> E{FB, 4096, ST, SSQ, BI_WIN, 4096};
                pg8::gemm_phase<pg8::EpiBf16<2>, pg8::StaticOrder>(L, g, S, E, tid);
            }
            PHASE_END
            PHASE_BEGIN_C(4)
            {
                LAS f32x2* ms = (LAS f32x2*)L;
                LAS unsigned char* vn = L + 1024;
                LAS unsigned char* wsl = L + 67584;
                const float* lng = A_->gm_ln_g + (size_t)jl * 2048; const float* lnb = A_->gm_ln_b + (size_t)jl * 2048;
                const int fr = lane & 15, fq = lane >> 4;
                const int sr = tid >> 2, spart = tid & 3, ccs = (tid & 31) * 8;
                int last_g = -1;
                float zf_ = 0.f; asm volatile("" : "+v"(zf_)); const f32x4 zero4 = {zf_, zf_, zf_, zf_};
                v4u raw[8]; f32x2 stp[8]; f32x4 ga, gb, ba, bb;
                ga = gb = ba = bb = zero4;
#define SP_PREFETCH(it_) do { const int row0_ = ((it_) >> 3) * 128, c0_ = ((it_) & 7) * 256; \
        _Pragma("unroll") for (int i = 0; i < 8; ++i) raw[i] = *(const v4u*)(FB + (size_t)(row0_ + ((tid + 512 * i) >> 5)) * 4096 + 2048 + c0_ + ccs); \
        const f32x2* sp_ = (const f32x2*)ST + (size_t)(row0_ + sr) * 32 + spart * 8; \
        _Pragma("unroll") for (int j = 0; j < 8; ++j) stp[j] = sp_[j]; } while (0)
                { const int it0_ = bx < 1024 ? bx : 0; SP_PREFETCH(it0_); }
                for (int it = bx; it < 1024; it += G) {
                    const int chunk = it >> 3, g = it & 7, row0 = chunk * 128, c0 = g * 256;
                    { float s = 0.f, q = 0.f;
#pragma unroll
                      for (int j = 0; j < 8; ++j) { s += stp[j][0]; q += stp[j][1]; }
                      s += __shfl_xor(s, 1); s += __shfl_xor(s, 2); q += __shfl_xor(q, 1); q += __shfl_xor(q, 2);
                      const float mean = s * (1.f / 2048.f), var = q * (1.f / 2048.f) - mean * mean;
                      if (spart == 0) ms[sr] = (f32x2){mean, rsqrtf(fmaxf(var, 0.f) + EPS)}; }
                    if (g != last_g) {
                        const bf16* wsg = WSB + (size_t)g * 128 * 128;
#pragma unroll
                        for (int k = 0; k < 4; ++k) { const int id = tid + 512 * k, row = id >> 4, c16 = id & 15;
                            *(LAS v4u*)(wsl + row * 272 + c16 * 16) = *(const v4u*)(wsg + (size_t)row * 128 + c16 * 8); }
                        ga = *(const f32x4*)(lng + c0 + ccs); gb = *(const f32x4*)(lng + c0 + ccs + 4); ba = *(const f32x4*)(lnb + c0 + ccs); bb = *(const f32x4*)(lnb + c0 + ccs + 4);
                        last_g = g; }
                    __syncthreads();
#pragma unroll
                    for (int i = 0; i < 8; ++i) { const int p = (tid + 512 * i) >> 5;
                        const f32x2 m2 = ms[p]; const v4u rw = raw[i];
                        const float y0 = (bf_lo(rw.x) - m2[0]) * m2[1] * ga[0] + ba[0], y1 = (bf_hi(rw.x) - m2[0]) * m2[1] * ga[1] + ba[1];
                        const float y2 = (bf_lo(rw.y) - m2[0]) * m2[1] * ga[2] + ba[2], y3 = (bf_hi(rw.y) - m2[0]) * m2[1] * ga[3] + ba[3];
                        const float y4 = (bf_lo(rw.z) - m2[0]) * m2[1] * gb[0] + bb[0], y5 = (bf_hi(rw.z) - m2[0]) * m2[1] * gb[1] + bb[1];
                        const float y6 = (bf_lo(rw.w) - m2[0]) * m2[1] * gb[2] + bb[2], y7 = (bf_hi(rw.w) - m2[0]) * m2[1] * gb[3] + bb[3];
                        LAS unsigned* dst = (LAS unsigned*)(vn + p * 516 + ccs * 2);
                        dst[0] = pk2(y0, y1); dst[1] = pk2(y2, y3); dst[2] = pk2(y4, y5); dst[3] = pk2(y6, y7); }
                    v2u uu[8][2]; float bqv[8];
                    { const float* bsg_ = A_->gm_bs + (size_t)jl * 1024 + g * 128;
#pragma unroll
                      for (int qb = 0; qb < 8; ++qb) bqv[qb] = bsg_[qb * 16 + fr]; }
#pragma unroll
                    for (int qb = 0; qb < 8; ++qb)
#pragma unroll
                        for (int cb = 0; cb < 2; ++cb) uu[qb][cb] = *(const v2u*)(FB + (size_t)(row0 + qb * 16 + fr) * 4096 + c0 + wave * 32 + cb * 16 + fq * 4);
                    __syncthreads();
                    { const int itn_ = it + G < 1024 ? it + G : it; SP_PREFETCH(itn_); }
                    f32x4 acc[2][8];
#pragma unroll
                    for (int cb = 0; cb < 2; ++cb)
#pragma unroll
                        for (int qb = 0; qb < 8; ++qb) acc[cb][qb] = zero4;
#pragma unroll 1
                    for (int ks = 0; ks < 4; ++ks) {
                        s16x8 af[2];
#pragma unroll
                        for (int cb = 0; cb < 2; ++cb) { const LAS unsigned short* vp = (const LAS unsigned short*)(vn + (ks * 32 + fq * 8) * 516 + (wave * 32 + cb * 16 + fr) * 2);
#pragma unroll
                            for (int j = 0; j < 8; ++j) af[cb][j] = (short)vp[j * 258]; }
#pragma unroll
                        for (int qb = 0; qb < 8; ++qb) { const s16x8 bfr = *(const LAS s16x8*)(wsl + (qb * 16 + fr) * 272 + ks * 64 + fq * 16);
                            acc[0][qb] = __builtin_amdgcn_mfma_f32_16x16x32_bf16(af[0], bfr, acc[0][qb], 0, 0, 0);
                            acc[1][qb] = __builtin_amdgcn_mfma_f32_16x16x32_bf16(af[1], bfr, acc[1][qb], 0, 0, 0); }
                    }
#pragma unroll
                    for (int qb = 0; qb < 8; ++qb) { const int q = qb * 16 + fr; const float bq = bqv[qb]; const size_t tok = (size_t)(row0 + q);
#pragma unroll
                        for (int cb = 0; cb < 2; ++cb) { const int ch = c0 + wave * 32 + cb * 16 + fq * 4;
                            const v2u u2 = uu[qb][cb];
                            const f32x4 sv = acc[cb][qb] + bq;
                            *(v2u*)(GB + tok * 2048 + ch) = (v2u){pk2(bf_lo(u2.x) * sv[0], bf_hi(u2.x) * sv[1]), pk2(bf_lo(u2.y) * sv[2], bf_hi(u2.y) * sv[3])}; } }
                    __syncthreads();
                }
#undef SP_PREFETCH
            }
            PHASE_END
            PHASE_BEGIN
            {
                pg8::Gemm g{GB, WOUTT, MLAT, DM, 2048, 2048, 0, 2048}; pg8::StaticOrder S; S.init(MLAT, DM, G, bx);
                pg8::EpiRes E{nullptr, nullptr, H16, modl + 2 * 1024, nullptr, AB, ng1, modl + 4 * 1024, SSQ};
                pg8::gemm_phase<pg8::EpiRes, pg8::StaticOrder>(L, g, S, E, tid);
            }
            PHASE_END
        }
        PHASE_BEGIN_C(5)
        {
            pg8::Gemm g{AB, W1T + (size_t)layer * DM * DFF, nrows, DFF, DM, DM, 0, DM}; pg8::StaticOrder S; S.init(nrows, DFF, G, bx);
            pg8::EpiBf16<1> E{FB, DFF, nullptr, SSQ, BI_W1 + (size_t)layer * 3 * 4096, 4096};
            pg8::gemm_phase<pg8::EpiBf16<1>, pg8::StaticOrder>(L, g, S, E, tid);
            if (layer == 0) { const int fi = TAIL_FIRST(MALL / 256 * 16);
                if (bx >= fi) { LAS float* scr = (LAS float*)(L + wave * 16640); TR_RUN(2, 4096, (bx - fi) * NWAVES + wave, (G - fi) * NWAVES); } }
        }
        PHASE_END
        PHASE_BEGIN
        {
            if (layer == 0) {
                pg8::Gemm g{FB, W2T, MALL, DM, DFF, DFF, 0, DFF}; pg8::SplitOrder S; S.init(G, bx);
                pg8::EpiResSplit E{{nullptr, nullptr, H16, modl + 5 * 1024, nullptr, AB, ng0 + 2 * DM, modl + 3 * 6144 + 1024, SSQ}, CACC};
                pg8::gemm_phase<pg8::EpiResSplit, pg8::SplitOrder>(L, g, S, E, tid);
                { const int fi = TAIL_FIRST(MLAT / 256 * 4 + 32);
                  if (bx >= fi) { LAS float* scr = (LAS float*)(L + wave * 16640); TR_RUN(3, 3584, (bx - fi) * NWAVES + wave, (G - fi) * NWAVES);
                      BIAS_RUN(16384, 18432, (bx - fi) * NWAVES + wave, (G - fi) * NWAVES); } }
            } else {
                pg8::Gemm g{FB, W2T + (size_t)layer * DM * DFF, MLAT, DM, DFF, DFF, 0, DFF}; pg8::StaticOrder S; S.init(MLAT, DM, G, bx);
                pg8::EpiRes E{nullptr, nullptr, H16, modl + 5 * 1024, nullptr, next_hb ? AB : nullptr, ng0 + 2 * DM, modl + 3 * 6144 + 1024, SSQ};
                pg8::gemm_phase<pg8::EpiRes, pg8::StaticOrder>(L, g, S, E, tid);
            }
        }
        PHASE_END
        if (layer == 0) {
            PHASE_BEGIN
            {
                const float* wg = ng0 + 2 * DM; const float* wsc = modl + 3 * 6144 + 1024 + 2 * 6144;
                for (int r = gw; r < MCTX; r += NGW) { const f32x4* xr = (const f32x4*)(CACC + (size_t)r * DM) + lane; unsigned long long* h8 = (unsigned long long*)(H16 + (size_t)(MLAT + r) * DM) + lane; f32x4 v[4]; float ss = 0.f;
#pragma unroll
                    for (int j = 0; j < 4; ++j) { const unsigned long long hw_ = h8[64 * j]; const unsigned lo_ = (unsigned)hw_, hi_ = (unsigned)(hw_ >> 32);
                        v[j] = (f32x4){bf_lo(lo_), bf_hi(lo_), bf_lo(hi_), bf_hi(hi_)} + ((xr[64 * j] + xr[64 * j + MCTX * DM / 4]) + (xr[64 * j + 2 * (MCTX * DM / 4)] + xr[64 * j + 3 * (MCTX * DM / 4)]));
                        h8[64 * j] = (unsigned long long)pk2(v[j][0], v[j][1]) | ((unsigned long long)pk2(v[j][2], v[j][3]) << 32);
                        ss += (v[j][0] * v[j][0] + v[j][1] * v[j][1]) + (v[j][2] * v[j][2] + v[j][3] * v[j][3]); }
                    ss = wave_sum(ss); if (lane < 16) SSQ[(size_t)(MLAT + r) * 16 + lane] = lane == 0 ? ss : 0.f;
                    unsigned long long* o8 = (unsigned long long*)(AB + (size_t)(MLAT + r) * DM) + lane;
#pragma unroll
                    for (int j = 0; j < 4; ++j) { const f32x4 y = v[j] * (*(const f32x4*)(wg + 4 * lane + 256 * j)) * (*(const f32x4*)(wsc + 4 * lane + 256 * j) + 1.0f);
                        o8[64 * j] = (unsigned long long)pk2(y[0], y[1]) | ((unsigned long long)pk2(y[2], y[3]) << 32); } }
            }
            PHASE_END
        }
    }
    PHASE_BEGIN
    {
        f32x4 g4[4];
#pragma unroll
        for (int j = 0; j < 4; ++j) g4[j] = *(const f32x4*)(A_->final_g + 4 * lane + 256 * j);
        for (int row = gw; row < MLAT; row += 4 * NGW) {
            int rw[4]; unsigned long long rr[4][4];
#pragma unroll
            for (int k = 0; k < 4; ++k) { rw[k] = row + k * NGW < MLAT ? row + k * NGW : row; const unsigned long long* hp = (const unsigned long long*)(H16 + (size_t)rw[k] * DM) + lane;
#pragma unroll
                for (int j = 0; j < 4; ++j) rr[k][j] = hp[64 * j]; }
#pragma unroll
            for (int k = 0; k < 4; ++k) { f32x4 v[4]; float ss = 0.f;
#pragma unroll
                for (int j = 0; j < 4; ++j) { const unsigned lo_ = (unsigned)rr[k][j], hi_ = (unsigned)(rr[k][j] >> 32);
                    v[j] = (f32x4){bf_lo(lo_), bf_hi(lo_), bf_lo(hi_), bf_hi(hi_)}; ss += (v[j][0] * v[j][0] + v[j][1] * v[j][1]) + (v[j][2] * v[j][2] + v[j][3] * v[j][3]); }
#pragma unroll
                for (int o = 1; o < 64; o <<= 1) ss += __shfl_xor(ss, o);
                const float rs = rsqrtf(ss * (1.f / DM) + EPS);
                f32x4* op = (f32x4*)(A_->out + (size_t)rw[k] * DM) + lane;
#pragma unroll
                for (int j = 0; j < 4; ++j) op[64 * j] = v[j] * rs * g4[j]; }
        }
    }
    PHASE_END
#undef PHASE_BEGIN
#undef TR_DECODE
#undef TR_SETMAP
#undef TR_RUN
#undef BIAS_RUN
#undef TAIL_FIRST
#undef PHASE_BEGIN_C
#undef PHASE_END
}

constexpr int N_PHASES = 1 + (2 + 3) + (3 + 2) + (3 + 2) + (2 + 2) + 1;

extern "C" void kernel_launch(void* const* d_in, const int* in_sizes, int n_in, void* d_out, int out_size, void* d_ws, size_t ws_size, hipStream_t stream) {
    static int grid = 0;
    if (grid == 0) {
        if (n_in != 22 || out_size != MLAT * DM || ws_size < WS_END) { fprintf(stderr, "kernel_launch: unexpected shapes: n_in %d out %d ws %zu (need %zu)\n", n_in, out_size, ws_size, (size_t)WS_END); grid = -1; return; }
        int dev = 0, cus = 0, per_cu = 0;
        hipGetDevice(&dev); hipDeviceGetAttribute(&cus, hipDeviceAttributeMultiprocessorCount, dev);
        if (hipFuncSetAttribute((const void*)fwd_kernel, hipFuncAttributeMaxDynamicSharedMemorySize, LDS_BYTES) != hipSuccess) { fprintf(stderr, "kernel_launch: hipFuncSetAttribute failed\n"); grid = -1; return; }
        if (hipOccupancyMaxActiveBlocksPerMultiprocessor(&per_cu, (const void*)fwd_kernel, NWAVES * 64, LDS_BYTES) != hipSuccess || per_cu < 1) { fprintf(stderr, "kernel_launch: occupancy query gave %d\n", per_cu); per_cu = 1; }
        (void)hipGetLastError();
        grid = cus * per_cu;
        fprintf(stderr, "kernel_launch: grid %d (cus %d x %d)\n", grid, cus, per_cu);
    }
    if (grid < 0) return;
    Args a{};
    const float** ap = (const float**)&a;
    for (int i = 0; i < 22; ++i) ap[i] = (const float*)d_in[i];
    a.out = (float*)d_out; a.ws = (unsigned char*)d_ws;
#if MK_N_LAUNCHES == 1
    a.ph_lo = 0; a.ph_hi = N_PHASES;
    if (hipMemsetAsync((char*)d_ws + WS_BAR, 0, XCD_BAR_WORDS * 4, stream) != hipSuccess) fprintf(stderr, "kernel_launch: memset of barrier words failed\n");
    void* kargs[] = {&a};
    hipError_t e = hipLaunchCooperativeKernel((const void*)fwd_kernel, dim3(grid), dim3(NWAVES * 64), kargs, LDS_BYTES, stream);
    if (e != hipSuccess) fprintf(stderr, "kernel_launch: cooperative launch failed: %s (grid %d)\n", hipGetErrorString(e), grid);
#else
    for (int p = 0; p < N_PHASES; ++p) { a.ph_lo = p; a.ph_hi = p + 1;
        hipLaunchKernelGGL(fwd_kernel, dim3(grid), dim3(NWAVES * 64), LDS_BYTES, stream, a); }
#endif
}
```

```cpp
#include <hip/hip_runtime.h>
#include <hip/hip_cooperative_groups.h>
#include <hip/hip_bf16.h>
#include <cstdio>
#include <cstdint>
namespace cg = cooperative_groups;

#ifndef PROBE_MASK
#define PROBE_MASK 0u
#endif
#ifndef MK_N_LAUNCHES
#define MK_N_LAUNCHES 1
#endif

constexpr int DM = 1024, SEQ = 8192, NB = 2, CTXL = 256, DFF = 4096, DEPTH = 4;
constexpr int MLAT = NB * SEQ;
constexpr int MCTX = NB * CTXL;
constexpr int MALL = MLAT + MCTX;
constexpr int SKV = CTXL + SEQ;
constexpr float EPS = 1e-6f;

namespace pg8 {
#define PG8_LAS __attribute__((address_space(3)))
typedef unsigned short bf16_t;
typedef short bf16x8 __attribute__((ext_vector_type(8)));
typedef float f32x4 __attribute__((ext_vector_type(4)));
typedef float f32x2 __attribute__((ext_vector_type(2)));
typedef unsigned u32x4 __attribute__((ext_vector_type(4)));
typedef unsigned u32x2 __attribute__((ext_vector_type(2)));
constexpr int BM = 256, BK = 64, HALF = 128, HTB = HALF * BK * 2, STAGE_BYTES = 8 * HTB, NXCD = 8, WGM = 4;

__host__ __device__ __forceinline__ int lds_byte(int r, int c) { const int st = (r >> 4) * 2 + (c >> 5), rr = r & 15, cc = c & 31, ob = rr * 64 + cc * 2; return st * 1024 + (ob ^ (((ob >> 9) & 1) << 5)); }
__host__ __device__ __forceinline__ void stage_rc(int b, int& R, int& C) { const int st = b / 1024, sb = b % 1024, swz = sb ^ (((sb >> 9) & 1) << 5); R = (st >> 1) * 16 + swz / 64; C = (st & 1) * 32 + (swz % 64) / 2; }
__host__ __device__ __forceinline__ int perm32(int rho) { const int n = rho >> 4, i = rho & 15; return 8 * (i >> 2) + 4 * n + (i & 3); }

struct Unit { int pm, pn, ks; };
struct Gemm { const bf16_t* A; const bf16_t* Bt; int M, N, K, lda, a_pn_off, ldb; };

struct StaticOrder {
    int nM, nN, nwg, G, c;
    __host__ __device__ void init(int M, int N, int G_, int c_) { nM = M / BM; nN = N / BM; nwg = nM * nN; G = G_; c = c_; }
    __host__ __device__ bool next(int i, Unit& u) const {
        const long L = (long)i * G + c; if (L >= nwg) return false;
        int wgid = (int)L; { const int q = nwg / NXCD, r = nwg % NXCD, xcd = wgid % NXCD, off = wgid / NXCD; wgid = (xcd < r ? xcd * (q + 1) : r * (q + 1) + (xcd - r) * q) + off; }
        const int nig = WGM * nN, gid = wgid / nig, fm = gid * WGM, gsz = (nM - fm) < WGM ? (nM - fm) : WGM;
        u.pm = fm + ((wgid % nig) % gsz); u.pn = (wgid % nig) / gsz; return true;
    }
    __device__ __forceinline__ size_t koff(const Unit&) const { return 0; }
    __device__ __forceinline__ int nt(const Unit&, int d) const { return d; }
};
struct SplitOrder {
    StaticOrder so; int G, c;
    __device__ void init(int G_, int c_) { so.init(MLAT, DM, G_, c_); G = G_; c = c_; }
    __device__ bool next(int i, Unit& u) const {
        const long L = (long)i * G + c;
        if (L < so.nwg) { const bool r = so.next(i, u); u.ks = 0; return r; }
        const int j = (int)(L - so.nwg); if (j >= 32) return false;
        u.pm = 64 + (j >> 4); u.pn = (j >> 2) & 3; u.ks = j & 3; return true;
    }
    __device__ __forceinline__ size_t koff(const Unit& u) const { return u.pm >= 64 ? (size_t)u.ks * 2048 : 0; }
    __device__ __forceinline__ int nt(const Unit& u, int d) const { return u.pm >= 64 ? 16 : d; }
};

__device__ __forceinline__ unsigned cvt_pk_bf16(float lo, float hi) { unsigned r; asm volatile("v_cvt_pk_bf16_f32 %0, %1, %2" : "=v"(r) : "v"(lo), "v"(hi)); return r; }
__device__ __forceinline__ float gelu_tanh(float x) {
    const float u = x * (0.7978845608f + 0.0356774081f * x * x);
    const float e = __builtin_amdgcn_exp2f(u * 2.8853900818f);
    return x - x * __builtin_amdgcn_rcpf(e + 1.0f);
}

template <int ACT  > struct EpiBf16 {
    static constexpr bool PERM = true;
    bf16_t* O; int ldc; float* stats; const float* ssq; const float* bias; int nbias;
    __device__ __forceinline__ void operator()(const f32x4 (&acc)[2][2][4][2], const Unit& u, int wr, int wc, int fr, int fq) const {
        const int rowt = u.pm * BM, b = rowt >= MLAT ? 2 : (rowt >> 13);
        const int row0 = rowt + wr * 64 + fr, col0 = u.pn * BM + wc * 32 + 8 * fq;
        f32x4 bv[2][2];
#pragma unroll
        for (int bj = 0; bj < 2; ++bj)
#pragma unroll
            for (int n = 0; n < 2; ++n) bv[bj][n] = *(const f32x4*)(bias + (size_t)b * nbias + col0 + bj * HALF + 4 * n);
        float rsv[2][4];
        { f32x4 pq[2][4];
#pragma unroll
          for (int ai = 0; ai < 2; ++ai)
#pragma unroll
              for (int m = 0; m < 4; ++m) pq[ai][m] = *(const f32x4*)(ssq + (size_t)(row0 + ai * HALF + m * 16) * 16 + 4 * fq);
#pragma unroll
          for (int ai = 0; ai < 2; ++ai)
#pragma unroll
              for (int m = 0; m < 4; ++m) { float t = (pq[ai][m][0] + pq[ai][m][1]) + (pq[ai][m][2] + pq[ai][m][3]); t += __shfl_xor(t, 16); t += __shfl_xor(t, 32);
                  rsv[ai][m] = rsqrtf(t * (1.f / DM) + EPS); } }
#pragma unroll
        for (int ai = 0; ai < 2; ++ai)
#pragma unroll
            for (int m = 0; m < 4; ++m) { const int row = row0 + ai * HALF + m * 16; bf16_t* rowp = O + (size_t)row * ldc + col0; float s = 0.f, q = 0.f;
                const float rstd = rsv[ai][m];
#pragma unroll
                for (int bj = 0; bj < 2; ++bj) { f32x4 v0 = acc[ai][bj][m][0] * rstd + bv[bj][0], v1 = acc[ai][bj][m][1] * rstd + bv[bj][1];
                    if (ACT == 1) {
#pragma unroll
                        for (int e = 0; e < 4; ++e) { const float a = fmaxf(v0[e], 0.f), b2 = fmaxf(v1[e], 0.f); v0[e] = a * a; v1[e] = b2 * b2; } }
                    if (ACT == 2) {
#pragma unroll
                        for (int e = 0; e < 4; ++e) { v0[e] = gelu_tanh(v0[e]); v1[e] = gelu_tanh(v1[e]); s += v0[e] + v1[e]; q += v0[e] * v0[e] + v1[e] * v1[e]; } }
                    u32x4 w; w.x = cvt_pk_bf16(v0[0], v0[1]); w.y = cvt_pk_bf16(v0[2], v0[3]); w.z = cvt_pk_bf16(v1[0], v1[1]); w.w = cvt_pk_bf16(v1[2], v1[3]);
                    *(u32x4*)(rowp + bj * HALF) = w; }
                if (ACT == 2) { if (u.pn >= 8) { s += __shfl_xor(s, 16); s += __shfl_xor(s, 32); q += __shfl_xor(q, 16); q += __shfl_xor(q, 32);
                    if (fq == 0) *(f32x2*)(stats + ((size_t)row * 32 + (u.pn - 8) * 4 + wc) * 2) = (f32x2){s, q}; } }
            }
    }
};
struct EpiRes {
    static constexpr bool PERM = true;
    const float* base_lat; const float* base_ctx;   bf16_t* h16; const float* gate;   const float* cs;
    bf16_t* hb; const float* wn_g; const float* wn_sc;   float* ssq;
    __device__ __forceinline__ void operator()(const f32x4 (&acc)[2][2][4][2], const Unit& u, int wr, int wc, int fr, int fq) const {
        asm volatile("" : "+v"(fr), "+v"(fq));
        const int rowt = u.pm * BM, b = rowt >= MLAT ? 2 : (rowt >> 13);
        const float* gp = gate + b * 6144; const int col0 = u.pn * BM + wc * 32 + 8 * fq;
        f32x4 gv[2][2], wv[2][2];
#pragma unroll
        for (int bj = 0; bj < 2; ++bj)
#pragma unroll
            for (int n = 0; n < 2; ++n) { gv[bj][n] = *(const f32x4*)(gp + col0 + bj * HALF + n * 4); if (cs) gv[bj][n] = gv[bj][n] * *(const f32x4*)(cs + col0 + bj * HALF + n * 4);
                if (hb) wv[bj][n] = *(const f32x4*)(wn_g + col0 + bj * HALF + n * 4) * (*(const f32x4*)(wn_sc + b * 6144 + col0 + bj * HALF + n * 4) + 1.0f); }
        const float* bb = base_lat ? (rowt >= MLAT ? base_ctx + (size_t)(rowt - MLAT) * DM : base_lat + (size_t)rowt * DM) : nullptr;
#pragma unroll
        for (int ai = 0; ai < 2; ++ai) {
            u32x4 raw[4][2];
#pragma unroll
            for (int m = 0; m < 4; ++m)
#pragma unroll
                for (int bj = 0; bj < 2; ++bj) raw[m][bj] = *(const u32x4*)(h16 + (size_t)rowt * DM + (size_t)(wr * 64 + fr + ai * HALF + m * 16) * DM + col0 + bj * HALF);
#pragma unroll
            for (int m = 0; m < 4; ++m) { const int rl = wr * 64 + fr + ai * HALF + m * 16; const size_t off = (size_t)rl * DM + col0; float sq = 0.f;
                bf16_t* hrow = h16 + (size_t)rowt * DM + off;
#pragma unroll
                for (int bj = 0; bj < 2; ++bj) { f32x4 b0, b1;
                    if (bb) { b0 = *(const f32x4*)(bb + off + bj * HALF); b1 = *(const f32x4*)(bb + off + bj * HALF + 4); }
                    else { const u32x4 r = raw[m][bj];
                        b0 = (f32x4){__uint_as_float(r.x << 16), __uint_as_float(r.x & 0xffff0000u), __uint_as_float(r.y << 16), __uint_as_float(r.y & 0xffff0000u)};
                        b1 = (f32x4){__uint_as_float(r.z << 16), __uint_as_float(r.z & 0xffff0000u), __uint_as_float(r.w << 16), __uint_as_float(r.w & 0xffff0000u)}; }
                    const f32x4 o0 = b0 + gv[bj][0] * acc[ai][bj][m][0], o1 = b1 + gv[bj][1] * acc[ai][bj][m][1];
                    u32x4 w; w.x = cvt_pk_bf16(o0[0], o0[1]); w.y = cvt_pk_bf16(o0[2], o0[3]); w.z = cvt_pk_bf16(o1[0], o1[1]); w.w = cvt_pk_bf16(o1[2], o1[3]);
                    *(u32x4*)(hrow + bj * HALF) = w;
                    sq += ((o0[0] * o0[0] + o0[1] * o0[1]) + (o0[2] * o0[2] + o0[3] * o0[3])) + ((o1[0] * o1[0] + o1[1] * o1[1]) + (o1[2] * o1[2] + o1[3] * o1[3]));
                    if (hb) { const f32x4 y0 = o0 * wv[bj][0], y1 = o1 * wv[bj][1]; u32x4 z; z.x = cvt_pk_bf16(y0[0], y0[1]); z.y = cvt_pk_bf16(y0[2], y0[3]); z.z = cvt_pk_bf16(y1[0], y1[1]); z.w = cvt_pk_bf16(y1[2], y1[3]);
                        *(u32x4*)(hb + (size_t)rowt * DM + off + bj * HALF) = z; } }
                if (ssq) { sq += __shfl_xor(sq, 16); sq += __shfl_xor(sq, 32); if (fq == 0) ssq[(size_t)(rowt + rl) * 16 + u.pn * 4 + wc] = sq; } }
        }
    }
};

struct EpiResSplit {
    static constexpr bool PERM = true;
    EpiRes base; float* cacc;
    __device__ __forceinline__ void operator()(const f32x4 (&acc)[2][2][4][2], const Unit& u, int wr, int wc, int fr, int fq) const {
        if (u.pm < 64) { base(acc, u, wr, wc, fr, fq); return; }
        asm volatile("" : "+v"(fr), "+v"(fq));
        const int rowt = u.pm * BM, col0 = u.pn * BM + wc * 32 + 8 * fq;
        const float* gp = base.gate + 2 * 6144;
        float* ob = cacc + (size_t)u.ks * MCTX * DM + (size_t)(rowt - MLAT) * DM;
        f32x4 gv[2][2];
#pragma unroll
        for (int bj = 0; bj < 2; ++bj)
#pragma unroll
            for (int n = 0; n < 2; ++n) gv[bj][n] = *(const f32x4*)(gp + col0 + bj * HALF + n * 4);
#pragma unroll
        for (int ai = 0; ai < 2; ++ai)
#pragma unroll
            for (int m = 0; m < 4; ++m) { float* o = ob + (size_t)(wr * 64 + fr + ai * HALF + m * 16) * DM + col0; asm volatile("" : "+v"(o));
#pragma unroll
                for (int bj = 0; bj < 2; ++bj)
#pragma unroll
                    for (int n = 0; n < 2; ++n) *(f32x4*)(o + bj * HALF + n * 4) = gv[bj][n] * acc[ai][bj][m][n]; }
    }
};

struct EpiQKV {
    static constexpr bool PERM = true;
    bf16_t* Q; bf16_t* K; bf16_t* V; const float* ssq; const float* bias; const float* qg; const float* kg; PG8_LAS float* P;
    __device__ __forceinline__ void operator()(f32x4 (&acc)[2][2][4][2], const Unit& u, int wr, int wc, int fr, int fq) const {
        asm volatile("" : "+v"(fr), "+v"(fq));
        const int rowt = u.pm * BM, b = rowt >= MLAT ? 2 : (rowt >> 13); const bool is_lat = rowt < MLAT;
        if (!is_lat && u.pn < 4) return;
        const int col0 = u.pn * BM + wc * 32 + 8 * fq;
        const bool qk = u.pn < 6;
        {   f32x4 bv[2][2];
#pragma unroll
            for (int bj = 0; bj < 2; ++bj)
#pragma unroll
                for (int n = 0; n < 2; ++n) bv[bj][n] = *(const f32x4*)(bias + (size_t)b * 2048 + col0 + bj * HALF + 4 * n);
            float rsv[2][4];
            { f32x4 pq[2][4];
#pragma unroll
              for (int ai = 0; ai < 2; ++ai)
#pragma unroll
                  for (int m = 0; m < 4; ++m) pq[ai][m] = *(const f32x4*)(ssq + (size_t)(rowt + wr * 64 + fr + ai * HALF + m * 16) * 16 + 4 * fq);
#pragma unroll
              for (int ai = 0; ai < 2; ++ai)
#pragma unroll
                  for (int m = 0; m < 4; ++m) { float t = (pq[ai][m][0] + pq[ai][m][1]) + (pq[ai][m][2] + pq[ai][m][3]); t += __shfl_xor(t, 16); t += __shfl_xor(t, 32);
                      rsv[ai][m] = rsqrtf(t * (1.f / DM) + EPS); } }
#pragma unroll
            for (int ai = 0; ai < 2; ++ai)
#pragma unroll
                for (int m = 0; m < 4; ++m) { const int rl = wr * 64 + fr + ai * HALF + m * 16;
                    const float rstd = rsv[ai][m];
#pragma unroll
                    for (int bj = 0; bj < 2; ++bj) { const f32x4 v0 = acc[ai][bj][m][0] * rstd + bv[bj][0], v1 = acc[ai][bj][m][1] * rstd + bv[bj][1];
                        acc[ai][bj][m][0] = v0; acc[ai][bj][m][1] = v1;
                        if (qk) { float sq = ((v0[0] * v0[0] + v0[1] * v0[1]) + (v0[2] * v0[2] + v0[3] * v0[3])) + ((v1[0] * v1[0] + v1[1] * v1[1]) + (v1[2] * v1[2] + v1[3] * v1[3]));
                            sq += __shfl_xor(sq, 16); sq += __shfl_xor(sq, 32); if (fq == 0) P[(rl * 2 + bj) * 4 + wc] = sq; } } }
        }
        if (qk) { asm volatile("s_waitcnt lgkmcnt(0)" ::: "memory"); __builtin_amdgcn_s_barrier(); asm volatile("" ::: "memory"); }
        float gq[2][4], inv[2][2];
        { const float* gsrc = u.pn < 4 ? qg : kg;
#pragma unroll
          for (int n = 0; n < 2; ++n) {
#pragma unroll
            for (int e = 0; e < 4; ++e) { const int p = wc * 32 + 8 * fq + 4 * n + e; gq[n][e] = gsrc[(p >> 6) * 64 + (p & 1) * 32 + ((p & 63) >> 1)]; }
#pragma unroll
            for (int pr = 0; pr < 2; ++pr) inv[n][pr] = __builtin_amdgcn_exp2f(-(float)(16 * (wc & 1) + 4 * fq + 2 * n + pr) * 0.4152410118609203f); } }
        const int headbase = (u.pn & 1) * 2;
#pragma unroll
        for (int ai = 0; ai < 2; ++ai)
#pragma unroll
            for (int m = 0; m < 4; ++m) { const int rl = wr * 64 + fr + ai * HALF + m * 16, row = rowt + rl;
                int kvrow; float cs[2][2], sn[2][2];
                if (is_lat) { const int t = row & (SEQ - 1); kvrow = b * SKV + CTXL + t; const float pos = (float)((wc >> 1) ? (t & 63) : (t >> 6));
#pragma unroll
                    for (int n = 0; n < 2; ++n)
#pragma unroll
                        for (int pr = 0; pr < 2; ++pr) { const float a = pos * inv[n][pr]; cs[n][pr] = __cosf(a); sn[n][pr] = __sinf(a); } }
                else { kvrow = ((row - MLAT) >> 8) * SKV + ((row - MLAT) & (CTXL - 1));
#pragma unroll
                    for (int n = 0; n < 2; ++n)
#pragma unroll
                        for (int pr = 0; pr < 2; ++pr) { cs[n][pr] = 1.f; sn[n][pr] = 0.f; } }
#pragma unroll
                for (int bj = 0; bj < 2; ++bj) { f32x4 v0 = acc[ai][bj][m][0], v1 = acc[ai][bj][m][1]; bf16_t* dst;
                    if (qk) { const f32x4 pt = *(const PG8_LAS f32x4*)(P + (rl * 2 + bj) * 4);
                        const float hr = rsqrtf(((pt[0] + pt[1]) + (pt[2] + pt[3])) * (1.f / 128.f) + EPS);
#pragma unroll
                        for (int e = 0; e < 4; ++e) { v0[e] = v0[e] * hr * gq[0][e]; v1[e] = v1[e] * hr * gq[1][e]; }
                        const f32x4 r0 = {v0[0] * cs[0][0] - v0[1] * sn[0][0], v0[0] * sn[0][0] + v0[1] * cs[0][0], v0[2] * cs[0][1] - v0[3] * sn[0][1], v0[2] * sn[0][1] + v0[3] * cs[0][1]};
                        const f32x4 r1 = {v1[0] * cs[1][0] - v1[1] * sn[1][0], v1[0] * sn[1][0] + v1[1] * cs[1][0], v1[2] * cs[1][1] - v1[3] * sn[1][1], v1[2] * sn[1][1] + v1[3] * cs[1][1]};
                        v0 = r0; v1 = r1;
                        dst = u.pn < 4 ? Q + (size_t)row * DM + (u.pn * 2 + bj) * 128 : K + (size_t)kvrow * 512 + ((u.pn - 4) * 2 + bj) * 128;
                    } else dst = V + (size_t)kvrow * 512 + ((u.pn - 6) * 2 + bj) * 128;
                    u32x4 w; w.x = cvt_pk_bf16(v0[0], v0[1]); w.y = cvt_pk_bf16(v0[2], v0[3]); w.z = cvt_pk_bf16(v1[0], v1[1]); w.w = cvt_pk_bf16(v1[2], v1[3]);
                    *(u32x4*)(dst + wc * 32 + 8 * fq) = w; } }
        (void)headbase;
    }
};

template <class Epi, class Sched>
__device__ __forceinline__ void gemm_phase(PG8_LAS unsigned char* lds, const Gemm g, const Sched& S, const Epi& E, const int tid) {
    const int wid = __builtin_amdgcn_readfirstlane(tid >> 6), lane = tid & 63, wr = wid >> 2, wc = wid & 3, fr = lane & 15, fq = lane >> 4;
    const int K = g.K, nt = K / BK, lda = g.lda, ldb = g.ldb;
    unsigned voffA[2], voffB[2];
#pragma unroll
    for (int i = 0; i < 2; ++i) { int R, C; stage_rc(tid * 16 + i * 8192, R, C); const int Rb = Epi::PERM ? ((R & ~31) + perm32(R & 31)) : R;
        voffA[i] = (unsigned)(R * lda + C) * 2u; voffB[i] = (unsigned)(Rb * ldb + C) * 2u; }
    const size_t kstep = (size_t)(BK * 2);
    const size_t hstepA = (size_t)HALF * lda * 2, hstepB = (size_t)HALF * ldb * 2;
    const size_t tstepA = 2 * hstepA, tstepB = 2 * hstepB;
    const unsigned ldsw = (unsigned)wid * 1024u;
    const int aoff = lds_byte(wr * 64 + fr, fq * 8), boff = lds_byte(wc * 32 + fr, fq * 8);
#define PG8_SA(b, h) (((b) * 2 + (h)) * HTB)
#define PG8_SB(b, h) ((4 + (b) * 2 + (h)) * HTB)
#define PG8_STAGE(bufoff, gbase, voff) do { _Pragma("unroll") for (int _i = 0; _i < 2; ++_i) \
        __builtin_amdgcn_global_load_lds((const unsigned*)((const char*)(gbase) + (voff)[_i]), (PG8_LAS unsigned*)(lds + (bufoff) + ldsw + _i * 8192), 16, 0, 0); } while (0)
#define PG8_LDA(dst, b, h) do { _Pragma("unroll") for (int m = 0; m < 4; ++m) _Pragma("unroll") for (int k = 0; k < 2; ++k) dst[m][k] = *(const PG8_LAS bf16x8*)(lds + PG8_SA(b, h) + aoff + m * 2048 + k * 1024); } while (0)
#define PG8_LDB(dst, b, h) do { _Pragma("unroll") for (int n = 0; n < 2; ++n) _Pragma("unroll") for (int k = 0; k < 2; ++k) dst[n][k] = *(const PG8_LAS bf16x8*)(lds + PG8_SB(b, h) + boff + n * 2048 + k * 1024); } while (0)
#define PG8_MMA(ai, bj, At, Bt) do { __builtin_amdgcn_s_setprio(1); _Pragma("unroll") for (int m = 0; m < 4; ++m) _Pragma("unroll") for (int n = 0; n < 2; ++n) _Pragma("unroll") for (int k = 0; k < 2; ++k) \
        acc[ai][bj][m][n] = __builtin_amdgcn_mfma_f32_16x16x32_bf16(Bt[n][k], At[m][k], acc[ai][bj][m][n], 0, 0, 0); __builtin_amdgcn_s_setprio(0); } while (0)
#define PG8_WAIT_V(n) asm volatile("s_waitcnt vmcnt(" #n ")" ::: "memory")
#define PG8_WAIT_L(n) asm volatile("s_waitcnt lgkmcnt(" #n ")" ::: "memory")
#define PG8_BAR __builtin_amdgcn_s_barrier()
#define PG8_SCHED __builtin_amdgcn_sched_barrier(0)
    Unit cur, nxt; int ui = 0;
    if (!S.next(0, cur)) return;
    f32x4 acc[2][2][4][2];
#pragma unroll
    for (int a = 0; a < 2; ++a)
#pragma unroll
        for (int b = 0; b < 2; ++b)
#pragma unroll
            for (int m = 0; m < 4; ++m)
#pragma unroll
                for (int n = 0; n < 2; ++n) acc[a][b][m][n] = (f32x4){0.f, 0.f, 0.f, 0.f};
    bf16x8 At[4][2], B0[2][2], B1[2][2];
    const char* cA = (const char*)g.A + (size_t)cur.pm * tstepA + (size_t)cur.pn * g.a_pn_off + S.koff(cur); const char* cB = (const char*)g.Bt + (size_t)cur.pn * tstepB + S.koff(cur);
    PG8_STAGE(PG8_SB(0, 0), cB, voffB); PG8_STAGE(PG8_SB(0, 1), cB + hstepB, voffB); PG8_STAGE(PG8_SA(0, 0), cA, voffA); PG8_STAGE(PG8_SA(0, 1), cA + hstepA, voffA);
    if (wr == 1) PG8_BAR;
    PG8_WAIT_V(2); PG8_BAR;
    PG8_STAGE(PG8_SB(1, 0), cB + kstep, voffB); PG8_STAGE(PG8_SA(1, 0), cA + kstep, voffA); PG8_STAGE(PG8_SB(1, 1), cB + hstepB + kstep, voffB);
    PG8_WAIT_V(6); PG8_BAR;
    for (;;) {
        const bool has_next = S.next(ui + 1, nxt);
        const char* nA = has_next ? (const char*)g.A + (size_t)nxt.pm * tstepA + (size_t)nxt.pn * g.a_pn_off + S.koff(nxt) : cA; const char* nB = has_next ? (const char*)g.Bt + (size_t)nxt.pn * tstepB + S.koff(nxt) : cB;
        const int ntc = S.nt(cur, nt);
        for (int t = 0; t < ntc; t += 2) {
            const bool last = (t == ntc - 2);
            const char* a1 = cA + (size_t)(t + 1) * kstep;
            const char* a2 = last ? nA : cA + (size_t)(t + 2) * kstep; const char* b2 = last ? nB : cB + (size_t)(t + 2) * kstep;
            const char* a3 = a2 + kstep; const char* b3 = b2 + kstep;
            PG8_LDB(B0, 0, 0); PG8_LDB(B1, 0, 1); PG8_SCHED; PG8_LDA(At, 0, 0); PG8_STAGE(PG8_SA(1, 1), a1 + hstepA, voffA);
            PG8_WAIT_V(8); PG8_WAIT_L(0); PG8_BAR; PG8_MMA(0, 0, At, B0); PG8_MMA(0, 1, At, B1); PG8_BAR; PG8_SCHED;
            PG8_LDA(At, 0, 1); PG8_STAGE(PG8_SB(0, 0), b2, voffB); PG8_STAGE(PG8_SB(0, 1), b2 + hstepB, voffB); PG8_STAGE(PG8_SA(0, 0), a2, voffA);
            PG8_WAIT_V(8); PG8_WAIT_L(0); PG8_BAR; PG8_MMA(1, 0, At, B0); PG8_MMA(1, 1, At, B1); PG8_BAR; PG8_SCHED;
            PG8_LDB(B0, 1, 0); PG8_LDB(B1, 1, 1); PG8_SCHED; PG8_LDA(At, 1, 0); PG8_STAGE(PG8_SA(0, 1), a2 + hstepA, voffA);
            PG8_WAIT_V(8); PG8_WAIT_L(0); PG8_BAR; PG8_MMA(0, 0, At, B0); PG8_MMA(0, 1, At, B1); PG8_BAR; PG8_SCHED;
            PG8_LDA(At, 1, 1); PG8_STAGE(PG8_SB(1, 0), b3, voffB); PG8_STAGE(PG8_SB(1, 1), b3 + hstepB, voffB); PG8_STAGE(PG8_SA(1, 0), a3, voffA);
            PG8_WAIT_V(8); PG8_WAIT_L(0); PG8_BAR; PG8_MMA(1, 0, At, B0); PG8_MMA(1, 1, At, B1); PG8_BAR; PG8_SCHED;
        }
        if (wr == 0) PG8_BAR;
        E(acc, cur, wr, wc, fr, fq);
        if (!has_next) break;
#pragma unroll
        for (int a = 0; a < 2; ++a)
#pragma unroll
            for (int b = 0; b < 2; ++b)
#pragma unroll
                for (int m = 0; m < 4; ++m)
#pragma unroll
                    for (int n = 0; n < 2; ++n) acc[a][b][m][n] = (f32x4){0.f, 0.f, 0.f, 0.f};
        cur = nxt; cA = nA; cB = nB; ++ui;
        if (wr == 1) PG8_BAR;
    }
    PG8_WAIT_V(0);
    PG8_BAR;
#undef PG8_SA
#undef PG8_SB
#undef PG8_STAGE
#undef PG8_LDA
#undef PG8_LDB
#undef PG8_MMA
#undef PG8_WAIT_V
#undef PG8_WAIT_L
#undef PG8_BAR
#undef PG8_SCHED
}
}

namespace attn {
using bf16 = __hip_bfloat16;
constexpr int D = 128, NW = 8, QBLK = 32, KVBLK = 64;
constexpr float SCALE = 0.088388347648318440f;
constexpr float THR = 8.f;
constexpr int SDEPTH = 2;
constexpr int LDQ = 1024, LDK = 512, LDO = 1024;
constexpr size_t SHM_V = KVBLK * D * 2, SHM_K = KVBLK * D * 2, SHM_ATTN = 2 * SHM_V + 2 * SHM_K + NW * 64 * 4;
using bf16x8 = __attribute__((ext_vector_type(8))) short;
using s16x4  = __attribute__((ext_vector_type(4))) short;
using f32x16 = __attribute__((ext_vector_type(16))) float;
using u32x4  = __attribute__((ext_vector_type(4))) unsigned;
#define KSWZ(row, colB) ((row) * 256 + ((colB) ^ (((row) & 7) << 4)))
#define SBAR() __builtin_amdgcn_sched_barrier(0)
__device__ __forceinline__ int crow(int r, int hi) { return (r & 3) + 8 * (r >> 2) + 4 * hi; }
__device__ __forceinline__ unsigned cvtpk(float lo, float hi) { unsigned r; asm volatile("v_cvt_pk_bf16_f32 %0, %1, %2" : "=v"(r) : "v"(lo), "v"(hi)); return r; }
__device__ __forceinline__ bf16x8 ld8(const bf16* p) { return *reinterpret_cast<const bf16x8*>(p); }

__device__ __forceinline__ void partialSM(f32x16& p0, f32x16& p1, float mnC) {
  constexpr float C = SCALE * 1.4426950408889634f;
#pragma unroll
  for (int r = 0; r < 16; ++r) p0[r] = fmaf(p0[r], C, mnC);
#pragma unroll
  for (int r = 0; r < 16; ++r) p1[r] = fmaf(p1[r], C, mnC);
#pragma unroll
  for (int r = 0; r < 16; ++r) p0[r] = __builtin_amdgcn_exp2f(p0[r]);
}
__device__ __forceinline__ void finishSM(f32x16& p0, f32x16& p1, float& l_reg, bf16x8& pa0, bf16x8& pa1, bf16x8& pa2, bf16x8& pa3) {
#pragma unroll
  for (int r = 0; r < 16; ++r) p1[r] = __builtin_amdgcn_exp2f(p1[r]);
  float ps = 0;
#pragma unroll
  for (int r = 0; r < 16; ++r) ps += p0[r];
#pragma unroll
  for (int r = 0; r < 16; ++r) ps += p1[r];
  l_reg += ps;
#define PK4(P, BASE, OUT) do { unsigned a0 = cvtpk(P[BASE + 0], P[BASE + 1]), a1 = cvtpk(P[BASE + 2], P[BASE + 3]);   \
    unsigned b0 = cvtpk(P[BASE + 4], P[BASE + 5]), b1 = cvtpk(P[BASE + 6], P[BASE + 7]);                              \
    auto r0 = __builtin_amdgcn_permlane32_swap(a0, b0, false, false); auto r1 = __builtin_amdgcn_permlane32_swap(a1, b1, false, false); \
    u32x4 w = {r0[0], r1[0], r0[1], r1[1]}; OUT = *reinterpret_cast<bf16x8*>(&w); } while (0)
  PK4(p0, 0, pa0); PK4(p0, 8, pa1); PK4(p1, 0, pa2); PK4(p1, 8, pa3);
#undef PK4
}
__device__ __forceinline__ void qkt(f32x16& p0, f32x16& p1, const bf16* Ks, const bf16x8* qr, int r32, int hi) {
  p0 = f32x16{}; p1 = f32x16{};
#pragma unroll
  for (int d0 = 0; d0 < 8; ++d0) { int cb = (d0 * 16 + hi * 8) * 2;
    bf16x8 b0 = *reinterpret_cast<const bf16x8*>((const char*)Ks + KSWZ(r32, cb));
    bf16x8 b1 = *reinterpret_cast<const bf16x8*>((const char*)Ks + KSWZ(32 + r32, cb));
    p0 = __builtin_amdgcn_mfma_f32_32x32x16_bf16(b0, qr[d0], p0, 0, 0, 0);
    p1 = __builtin_amdgcn_mfma_f32_32x32x16_bf16(b1, qr[d0], p1, 0, 0, 0); }
}
__device__ __forceinline__ int v_st(int k, int c) { const int kk = (k & ~0xC) | ((k & 4) << 1) | ((k & 8) >> 1); return ((kk >> 3) * 4 + (c >> 5)) * 512 + ((kk & 7) * 32 + (c & 31)) * 2; }
__device__ __forceinline__ int v_rd_base(int lane) { return ((lane & 3) << 3) | (((lane >> 2) & 3) << 6) | (((lane >> 4) & 1) << 5) | (((lane >> 5) & 1) << 8); }
constexpr int v_rd_off(int d0, int ks, int half) { return d0 * 512 + ks * 4096 + half * 2048; }
template <int OFF> __device__ __forceinline__ s16x4 tr_read(int vb) {
  s16x4 r; asm volatile("ds_read_b64_tr_b16 %0, %1 offset:%2" : "=&v"(r) : "v"(vb), "i"(OFF) : "memory"); return r;
}
template <int D0> __device__ __forceinline__ void pv_one(f32x16& od, int vb, bf16x8 pa0, bf16x8 pa1, bf16x8 pa2, bf16x8 pa3) {
  const s16x4 l0 = tr_read<v_rd_off(D0, 0, 0)>(vb), h0 = tr_read<v_rd_off(D0, 0, 1)>(vb), l1 = tr_read<v_rd_off(D0, 1, 0)>(vb), h1 = tr_read<v_rd_off(D0, 1, 1)>(vb);
  const s16x4 l2 = tr_read<v_rd_off(D0, 2, 0)>(vb), h2 = tr_read<v_rd_off(D0, 2, 1)>(vb), l3 = tr_read<v_rd_off(D0, 3, 0)>(vb), h3 = tr_read<v_rd_off(D0, 3, 1)>(vb);
  asm volatile("s_waitcnt lgkmcnt(0)" ::: "memory"); SBAR();
#define PK(L, H) (bf16x8){L[0], L[1], L[2], L[3], H[0], H[1], H[2], H[3]}
  od = __builtin_amdgcn_mfma_f32_32x32x16_bf16(pa0, PK(l0, h0), od, 0, 0, 0);
  od = __builtin_amdgcn_mfma_f32_32x32x16_bf16(pa1, PK(l1, h1), od, 0, 0, 0);
  od = __builtin_amdgcn_mfma_f32_32x32x16_bf16(pa2, PK(l2, h2), od, 0, 0, 0);
  od = __builtin_amdgcn_mfma_f32_32x32x16_bf16(pa3, PK(l3, h3), od, 0, 0, 0);
#undef PK
}
__device__ __forceinline__ void pv_d0(f32x16* o, int vb, bf16x8 pa0, bf16x8 pa1, bf16x8 pa2, bf16x8 pa3) {
  pv_one<0>(o[0], vb, pa0, pa1, pa2, pa3); pv_one<1>(o[1], vb, pa0, pa1, pa2, pa3); pv_one<2>(o[2], vb, pa0, pa1, pa2, pa3); pv_one<3>(o[3], vb, pa0, pa1, pa2, pa3);
}

__device__ __forceinline__ void attn_dense_body(const bf16* __restrict__ Qb, const bf16* __restrict__ Kh, const bf16* __restrict__ Vh,
                                                bf16* __restrict__ Ob, int seq, char* lds, const int tid, const float mnC) {
  const int wid = tid >> 6, lane = tid & 63, r32 = lane & 31, hi = lane >> 5;
  bf16* V_lds = (bf16*)lds; bf16* K_lds = (bf16*)(lds + 2 * SHM_V);
  float* ws = (float*)(lds + 2 * SHM_V + 2 * SHM_K) + wid * 64; float* li_l = ws;
  float l_reg = 0; f32x16 o[4] = {}; bf16x8 qr[8];
  const bf16* Qw = Qb + (long)(wid * QBLK + r32) * LDQ + hi * 8;
#pragma unroll
  for (int d0 = 0; d0 < 8; ++d0) qr[d0] = ld8(Qw + d0 * 16);
  const int sr = tid >> 4, sc = (tid & 15) * 8, vst0 = v_st(sr, sc), vst1 = v_st(32 + sr, sc);
  const int vb0 = (int)(uintptr_t)V_lds + v_rd_base(lane);
  bf16x8 s0_vs0, s0_vs1, s0_ks0, s0_ks1;
#define SLOAD0(k0) do { s0_vs0 = ld8(&Vh[(long)((k0) + sr) * LDK + sc]); s0_vs1 = ld8(&Vh[(long)((k0) + 32 + sr) * LDK + sc]); \
    s0_ks0 = ld8(&Kh[(long)((k0) + sr) * LDK + sc]); s0_ks1 = ld8(&Kh[(long)((k0) + 32 + sr) * LDK + sc]); } while (0)
#define SWRITE0(b) do { *(bf16x8*)((char*)V_lds + (b) * SHM_V + vst0) = s0_vs0; *(bf16x8*)((char*)V_lds + (b) * SHM_V + vst1) = s0_vs1; const int kc = sc * 2; \
    *(bf16x8*)((char*)K_lds + (b) * SHM_K + KSWZ(sr, kc)) = s0_ks0; *(bf16x8*)((char*)K_lds + (b) * SHM_K + KSWZ(32 + sr, kc)) = s0_ks1; } while (0)
#define SWAIT() asm volatile("s_waitcnt vmcnt(0)" ::: "memory")
  f32x16 pA0, pA1, pB0, pB1; bf16x8 pa0, pa1, pa2, pa3; const int NT = seq / KVBLK;
  SLOAD0(0);
  bf16x8 t1_vs0 = ld8(&Vh[(long)(KVBLK + sr) * LDK + sc]), t1_vs1 = ld8(&Vh[(long)(KVBLK + 32 + sr) * LDK + sc]);
  bf16x8 t1_ks0 = ld8(&Kh[(long)(KVBLK + sr) * LDK + sc]), t1_ks1 = ld8(&Kh[(long)(KVBLK + 32 + sr) * LDK + sc]);
  asm volatile("s_waitcnt vmcnt(4)" ::: "memory"); SWRITE0(0); __syncthreads();
  qkt(pA0, pA1, K_lds, qr, r32, hi); partialSM(pA0, pA1, mnC);
  s0_vs0 = t1_vs0; s0_vs1 = t1_vs1; s0_ks0 = t1_ks0; s0_ks1 = t1_ks1;
  SWAIT(); SWRITE0(1); __syncthreads();
  if (__builtin_amdgcn_readfirstlane(wid) >= 4) __builtin_amdgcn_s_setprio(1);
  for (int j = 1; j + 1 < NT; j += 2) {
    SBAR(); qkt(pB0, pB1, (bf16*)((char*)K_lds + SHM_K), qr, r32, hi);
    finishSM(pA0, pA1, l_reg, pa0, pa1, pa2, pa3); SBAR();
    SLOAD0((j + 1) * KVBLK); SBAR();
    pv_d0(o, vb0, pa0, pa1, pa2, pa3); partialSM(pB0, pB1, mnC);
    __syncthreads(); SWAIT(); SWRITE0(0);
    SBAR(); __syncthreads();
    SBAR(); qkt(pA0, pA1, K_lds, qr, r32, hi);
    finishSM(pB0, pB1, l_reg, pa0, pa1, pa2, pa3); SBAR();
    SLOAD0((j + 2) * KVBLK); SBAR();
    pv_d0(o, vb0 + (int)SHM_V, pa0, pa1, pa2, pa3); partialSM(pA0, pA1, mnC);
    __syncthreads(); SWAIT(); SWRITE0(1);
    SBAR(); __syncthreads();
  }
  SBAR(); qkt(pB0, pB1, (bf16*)((char*)K_lds + SHM_K), qr, r32, hi);
  finishSM(pA0, pA1, l_reg, pa0, pa1, pa2, pa3); SBAR();
  pv_d0(o, vb0, pa0, pa1, pa2, pa3); partialSM(pB0, pB1, mnC);
  __syncthreads();
  finishSM(pB0, pB1, l_reg, pa0, pa1, pa2, pa3); SBAR();
  pv_d0(o, vb0 + (int)SHM_V, pa0, pa1, pa2, pa3);
  { auto rr = __builtin_amdgcn_permlane32_swap(__float_as_uint(l_reg), __float_as_uint(l_reg), false, false);
    l_reg = __uint_as_float(rr[0]) + __uint_as_float(rr[1]); }
  __builtin_amdgcn_s_setprio(0);
  if (hi == 0) li_l[r32] = l_reg; asm volatile("s_waitcnt lgkmcnt(0)" ::: "memory");
  float rli[16];
#pragma unroll
  for (int r = 0; r < 16; ++r) rli[r] = __builtin_amdgcn_rcpf(li_l[crow(r, hi)]);
  bf16* Ow = Ob + (long)(wid * QBLK) * LDO;
#pragma unroll
  for (int r = 0; r < 16; ++r) { const int orow = crow(r, hi);
#pragma unroll
    for (int d0 = 0; d0 < 4; ++d0) Ow[(long)orow * LDO + d0 * 32 + r32] = __float2bfloat16(o[d0][r] * rli[r]); }
  __syncthreads();
#undef SLOAD0
#undef SWRITE0
#undef SWAIT
}
}

#define LAS __attribute__((address_space(3)))
typedef unsigned short bf16;
typedef float f32x4 __attribute__((ext_vector_type(4)));
typedef float f32x2 __attribute__((ext_vector_type(2)));
typedef unsigned v4u __attribute__((ext_vector_type(4)));
typedef unsigned v2u __attribute__((ext_vector_type(2)));
typedef short s16x8 __attribute__((ext_vector_type(8)));

constexpr int NWAVES = 8;
constexpr int LDS_BYTES = 147456;
constexpr size_t MiB = 1u << 20;
constexpr size_t WS_MOD  = 0;
constexpr size_t WS_W1   = 1 * MiB;
constexpr size_t WS_W2   = WS_W1 + 32 * MiB;
constexpr size_t WS_WIN  = WS_W2 + 32 * MiB;
constexpr size_t WS_WQKV = WS_WIN + 8 * MiB;
constexpr size_t WS_WO   = WS_WQKV + 4 * MiB;
constexpr size_t WS_WOUT = WS_WO + 2 * MiB;
constexpr size_t WS_WP   = WS_WOUT + 4 * MiB;
constexpr size_t WS_WS   = WS_WP + 1 * MiB;
constexpr size_t WS_HCTX = WS_WS + 1 * MiB;
constexpr size_t WS_A    = WS_HCTX + 2 * MiB;
constexpr size_t WS_F    = WS_A + 33 * MiB;
constexpr size_t WS_G    = WS_F + 132 * MiB;
constexpr size_t WS_ST   = WS_G + 64 * MiB;
constexpr size_t WS_SSQ  = WS_ST + 4 * MiB;
constexpr size_t WS_H16  = WS_SSQ + 2 * MiB;
constexpr size_t WS_END  = WS_H16 + 33 * MiB;
constexpr size_t WS_BIAS = 512 * 1024;
constexpr size_t WS_BAR  = 896 * 1024;
constexpr int LDS_BARST = LDS_BYTES - 64;
constexpr size_t F_Q = 66 * MiB, F_K = F_Q + 32 * MiB, F_V = F_K + 17 * MiB;
static_assert(F_V + 17 * MiB <= 132 * MiB, "Q|K|V inside F");

struct Args {
    const float *x, *c, *ctx, *c_ctx, *ada_w, *ada_b, *norm_g, *mlp_w1, *mlp_w2, *pool_w, *pool_scale, *attn_w_qkv, *attn_w_o, *attn_q_g, *attn_k_g,
                *gm_w_in, *gm_ln_g, *gm_ln_b, *gm_ws, *gm_bs, *gm_w_out, *final_g;
    float* out; unsigned char* ws; int ph_lo, ph_hi;
};

__device__ __forceinline__ unsigned f2bf(float f) { unsigned u = __builtin_bit_cast(unsigned, f); return (u + 0x7fffu + ((u >> 16) & 1u)) >> 16; }
__device__ __forceinline__ unsigned pk2(float lo, float hi) { return pg8::cvt_pk_bf16(lo, hi); }
__device__ __forceinline__ float bf_lo(unsigned w) { return __uint_as_float(w << 16); }
__device__ __forceinline__ float bf_hi(unsigned w) { return __uint_as_float(w & 0xffff0000u); }
__device__ __forceinline__ float wave_sum(float v) {
#pragma unroll
    for (int o = 1; o < 64; o <<= 1) v += __shfl_xor(v, o);
    return v;
}
__device__ __forceinline__ const float* rowp(const float* lat, const float* ctx, int row) { return row < MLAT ? lat + (size_t)row * DM : ctx + (size_t)(row - MLAT) * DM; }
__device__ __forceinline__ int bidx(int row) { return row >= MLAT ? 2 : (row >> 13); }


#define XB_TMO      128
#define XB_XCNT(j)  (256  + 64 * (j))
#define XB_XSUB(j)  (1280 + 64 * (j))
#define XB_XGEN(j)  (2304 + 64 * (j))
#define XB_TOP      3328
#define XB_TOPGEN   3392
#define XCD_BAR_WORDS 3456
#define XB_SPIN_CAP (1u << 18)
__device__ __forceinline__ unsigned xb_ld(unsigned* p)              { return __hip_atomic_load(p, __ATOMIC_RELAXED, __HIP_MEMORY_SCOPE_AGENT); }
__device__ __forceinline__ unsigned xb_add(unsigned* p, unsigned v) { return __hip_atomic_fetch_add(p, v, __ATOMIC_RELAXED, __HIP_MEMORY_SCOPE_AGENT); }
__device__ __forceinline__ unsigned xb_xcc_id() { return (unsigned)__builtin_amdgcn_s_getreg((3 << 11) | 20) & 0xFu; }
#define XB_SPIN(cond, bar) do { unsigned _sp = 0; while (cond) { __builtin_amdgcn_s_sleep(1); \
    if ((++_sp & 255u) == 0u) { if (xb_ld(&(bar)[XB_TMO])) break; if (_sp > XB_SPIN_CAP) { atomicAdd(&(bar)[XB_TMO], 1u); break; } } } } while (0)
struct XcdBarrier { unsigned* bar; unsigned x; volatile LAS unsigned* st; };
__device__ __forceinline__ XcdBarrier xcd_barrier_post(unsigned* bar, volatile LAS unsigned* st, int tid) {
    XcdBarrier b; b.bar = bar; b.x = xb_xcc_id(); b.st = st;
    if (tid == 0) (void)xb_add(&bar[XB_XCNT(b.x)], 1u);
    return b;
}
__device__ __forceinline__ void xcd_barrier_complete(unsigned* bar, unsigned x, unsigned& nloc, unsigned& nx) {
    const unsigned G = gridDim.x * gridDim.y * gridDim.z;
    unsigned sum, cnt, mine, sp = 0u;
    for (;;) {
        sum = 0u; cnt = 0u; mine = 0u;
#pragma unroll
        for (unsigned j = 0; j < 16; ++j) { const unsigned c = xb_ld(&bar[XB_XCNT(j)]); sum += c; cnt += (c > 0u) ? 1u : 0u; mine = (j == x) ? c : mine; }
        if (sum == G) break;
        __builtin_amdgcn_s_sleep(1);
        if ((++sp & 255u) == 0u) { if (xb_ld(&bar[XB_TMO])) break; if (sp > XB_SPIN_CAP) { atomicAdd(&bar[XB_TMO], 1u); break; } }
    }
    nloc = mine > 0u ? mine : 1u; nx = cnt > 0u ? cnt : 1u;
}
__device__ __forceinline__ void xcd_barrier(const XcdBarrier& b, int tid) {
    asm volatile("s_waitcnt vmcnt(0)" ::: "memory");
    __syncthreads();
    if (tid == 0) {
        unsigned* bar = b.bar;
        __builtin_amdgcn_s_waitcnt(0);
        unsigned nloc = b.st[0], nx = b.st[1];
        if (nloc == 0u) { xcd_barrier_complete(bar, b.x, nloc, nx); b.st[0] = nloc; b.st[1] = nx; }
        const unsigned old = xb_add(&bar[XB_XSUB(b.x)], 1u);
        const unsigned gen = old / nloc;
        if (old + 1u == (gen + 1u) * nloc) {
            __builtin_amdgcn_fence(__ATOMIC_RELEASE, "agent");
            asm volatile("s_waitcnt vmcnt(0)" ::: "memory");
            const unsigned og = xb_add(&bar[XB_TOP], 1u);
            const unsigned tg = og / nx;
            if (og + 1u == (tg + 1u) * nx) xb_add(&bar[XB_TOPGEN], 1u);
            else XB_SPIN(xb_ld(&bar[XB_TOPGEN]) == tg, bar);
            __builtin_amdgcn_fence(__ATOMIC_ACQUIRE, "agent");
            xb_add(&bar[XB_XGEN(b.x)], 1u);
            asm volatile("s_waitcnt vmcnt(0)" ::: "memory");
        } else {
            XB_SPIN(xb_ld(&bar[XB_XGEN(b.x)]) == gen, bar);
            __builtin_amdgcn_fence(__ATOMIC_ACQUIRE, "agent");
            asm volatile("s_waitcnt vmcnt(0)" ::: "memory");
        }
    }
    __syncthreads();
}

struct TrD { const float* W; bf16* WT; int K, N, item, perm; };
__device__ __forceinline__ void tr_load(const TrD& d, int lane, f32x4 (&v)[16]) {
    const int nblk = d.N / 64, kb = d.item / nblk, nb = d.item % nblk, k0 = 64 * kb, n0 = 64 * nb, lr = lane >> 4, lc = (lane & 15) * 4;
    const float* src = d.W + (size_t)(k0 + lr) * d.N + n0 + lc;
#pragma unroll
    for (int i = 0; i < 16; ++i) v[i] = __builtin_nontemporal_load((const f32x4*)(src + (size_t)(4 * i) * d.N));
}
__device__ __forceinline__ void tr_lds_write(LAS float* scr, int lane, const f32x4 (&v)[16]) {
    const int lr = lane >> 4, lc = (lane & 15) * 4;
#pragma unroll
    for (int i = 0; i < 16; ++i) { const int kk = 4 * i + lr; scr[kk * 65 + lc + 0] = v[i][0]; scr[kk * 65 + lc + 1] = v[i][1]; scr[kk * 65 + lc + 2] = v[i][2]; scr[kk * 65 + lc + 3] = v[i][3]; }
    asm volatile("s_waitcnt lgkmcnt(0)" ::: "memory");
}
__device__ __forceinline__ void tr_store(const TrD& d, LAS float* scr, int lane) {
    const int nblk = d.N / 64, kb = d.item / nblk, nb = d.item % nblk, k0 = 64 * kb, n0 = 64 * nb, c = lane & 7;
#pragma unroll
    for (int j = 0; j < 8; ++j) { const int n = (lane >> 3) + 8 * j; const LAS float* s = scr + (8 * c) * 65 + n;
        v4u o; o.x = pk2(s[0 * 65], s[1 * 65]); o.y = pk2(s[2 * 65], s[3 * 65]); o.z = pk2(s[4 * 65], s[5 * 65]); o.w = pk2(s[6 * 65], s[7 * 65]);
        int dn = n0 + n; if (d.perm && dn < 1536) { const int f = dn & 127; dn = (dn & ~127) | ((f >> 6) * 64 + 2 * (f & 31) + ((f >> 5) & 1)); }
        __builtin_nontemporal_store(o, (v4u*)(d.WT + (size_t)dn * d.K + k0 + 8 * c)); }
    asm volatile("s_waitcnt lgkmcnt(0)" ::: "memory");
}
__device__ __forceinline__ void norm_phase(const float* hl, const float* hc, int nrows, const float* ng, const float* modl  , int which_shift, bf16* out, int gw, int NGW, int lane) {
    f32x4 g4[4];
#pragma unroll
    for (int j = 0; j < 4; ++j) g4[j] = *(const f32x4*)(ng + 4 * lane + 256 * j);
    for (int row = gw; row < nrows; row += NGW) {
        const f32x4* xr = (const f32x4*)rowp(hl, hc, row) + lane;
        const float* mp = modl + bidx(row) * 6144 + which_shift * 1024;
        f32x4 v[4]; float ss = 0.f;
#pragma unroll
        for (int j = 0; j < 4; ++j) { v[j] = xr[64 * j]; ss += (v[j][0] * v[j][0] + v[j][1] * v[j][1]) + (v[j][2] * v[j][2] + v[j][3] * v[j][3]); }
        const float rstd = rsqrtf(wave_sum(ss) * (1.f / DM) + EPS);
        unsigned long long* o8 = (unsigned long long*)(out + (size_t)row * DM) + lane;
#pragma unroll
        for (int j = 0; j < 4; ++j) { const f32x4 sh = *(const f32x4*)(mp + 4 * lane + 256 * j), sc = *(const f32x4*)(mp + 1024 + 4 * lane + 256 * j);
            const f32x4 y = (v[j] * rstd * g4[j]) * (sc + 1.0f) + sh;
            o8[64 * j] = (unsigned long long)pk2(y[0], y[1]) | ((unsigned long long)pk2(y[2], y[3]) << 32); }
    }
}

__global__ void __launch_bounds__(NWAVES * 64, 2) fwd_kernel(Args args) {
    extern __shared__ __attribute__((aligned(16))) unsigned char lds[];
    cg::grid_group grid = cg::this_grid();
    LAS unsigned char* L = (LAS unsigned char*)lds;
    const int tid0 = threadIdx.x;
    const int G0 = gridDim.x, bx0 = blockIdx.x;
    typedef const __attribute__((address_space(4))) Args* ArgP;
    const ArgP argp = (ArgP)__builtin_amdgcn_kernarg_segment_ptr();
    ArgP A_ = argp;
#define WSP(T, off) ((T*)(A_->ws + (off)))
#define MOD   WSP(float, WS_MOD)
#define W1T   WSP(bf16, WS_W1)
#define W2T   WSP(bf16, WS_W2)
#define WINT  WSP(bf16, WS_WIN)
#define WQKVT WSP(bf16, WS_WQKV)
#define WOT   WSP(bf16, WS_WO)
#define WOUTT WSP(bf16, WS_WOUT)
#define WPT   WSP(bf16, WS_WP)
#define WSB   WSP(bf16, WS_WS)
#define CACC  WSP(float, WS_G)
#define H16   WSP(bf16, WS_H16)
#define AB    WSP(bf16, WS_A)
#define FB    WSP(bf16, WS_F)
#define GB    WSP(bf16, WS_G)
#define ST    WSP(float, WS_ST)
#define QB    WSP(bf16, WS_F + F_Q)
#define KB    WSP(bf16, WS_F + F_K)
#define VB    WSP(bf16, WS_F + F_V)
#define BI_W1  WSP(float, WS_BIAS)
#define BI_QKV WSP(float, WS_BIAS + 4 * 3 * 4096 * 4)
#define BI_WIN WSP(float, WS_BIAS + 4 * 3 * 4096 * 4 + 3 * 2048 * 4)
#define SSQ    WSP(float, WS_SSQ)
    const int lo = args.ph_lo, hi = args.ph_hi;
    int ph = 0;
    if (tid0 < 2) ((volatile LAS unsigned*)(L + LDS_BARST))[tid0] = 0u;
    __syncthreads();
    XcdBarrier xbar = xcd_barrier_post((unsigned*)(A_->ws + WS_BAR), (volatile LAS unsigned*)(L + LDS_BARST), tid0);
#define PHASE_BEGIN_C(cls) if (lo <= ph && ph < hi) { for (int rep_ = 0; rep_ <= ((PROBE_MASK >> (cls)) & 1); ++rep_) { int tid = tid0; asm volatile("" : "+v"(tid)); const int lane = tid & 63, wave = __builtin_amdgcn_readfirstlane(tid >> 6); int bx = bx0, G = G0; asm volatile("" : "+s"(bx), "+s"(G)); const int gw = bx * NWAVES + wave, NGW = G * NWAVES; (void)lane; (void)gw; (void)NGW; ArgP A_ = argp; asm volatile("" : "+s"(A_));
#define PHASE_BEGIN PHASE_BEGIN_C(31)
#define PHASE_END   } if (ph + 1 < hi) { if (lo < 0) grid.sync(); int tb_ = tid0; asm volatile("" : "+v"(tb_)); xcd_barrier(xbar, tb_); if ((PROBE_MASK >> 8) & 1) xcd_barrier(xbar, tb_); } } ++ph;

    constexpr int I_W = 1024, I_QKV = 512, I_O = 256, I_OUT = 512, I_P = 16;
#define TR_DECODE(r_, D) do { int r = (r_); \
            if (r < 4 * I_W) { const int l = r / I_W; D = TrD{A_->mlp_w1 + (size_t)l * DM * DFF, W1T + (size_t)l * DM * DFF, DM, DFF, r % I_W, 0}; break; } r -= 4 * I_W; \
            if (r < 4 * I_W) { const int l = r / I_W; D = TrD{A_->mlp_w2 + (size_t)l * DM * DFF, W2T + (size_t)l * DM * DFF, DFF, DM, r % I_W, 0}; break; } r -= 4 * I_W; \
            if (r < I_W) { D = TrD{A_->gm_w_in, WINT, DM, 4096, r, 0}; break; } r -= I_W; \
            if (r < I_QKV) { D = TrD{A_->attn_w_qkv, WQKVT, DM, 2048, r, 1}; break; } r -= I_QKV; \
            if (r < I_O) { D = TrD{A_->attn_w_o, WOT, DM, DM, r, 0}; break; } r -= I_O; \
            if (r < I_OUT) { D = TrD{A_->gm_w_out, WOUTT, 2048, DM, r, 0}; break; } r -= I_OUT; \
            { const int m = r / I_P; D = TrD{A_->pool_w + (size_t)m * 65536, WPT + (size_t)m * 65536, 256, 256, r % I_P, 0}; } } while (0)
#define TR_SETMAP(SET, j) ((SET) == 0 ? ((j) < 1024 ? (j) : 10496 + ((j) - 1024)) : \
                           (SET) == 1 ? ((j) < 512 ? 9216 + (j) : 9728 + ((j) - 512)) : \
                           (SET) == 2 ? ((j) < 1024 ? 1024 + (j) : ((j) < 2048 ? 5120 + ((j) - 1024) : ((j) < 3072 ? 8192 + ((j) - 2048) : 4096 + ((j) - 3072)))) : \
                           (SET) == 3 ? ((j) < 512 ? 9984 + (j) : ((j) < 1536 ? 2048 + ((j) - 512) : ((j) < 2560 ? 6144 + ((j) - 1536) : 3072 + ((j) - 2560)))) : \
                                        7168 + (j))
#define TR_RUN(SET, NSET, IW, NW) do { TrD d, dn; f32x4 v[16]; const int iw_ = (IW), nw_ = (NW); \
        { const int j0_ = iw_ < (NSET) ? iw_ : 0; TR_DECODE(TR_SETMAP(SET, j0_), d); } tr_load(d, lane, v); \
        for (int j = iw_; j < (NSET); j += nw_) { tr_lds_write(scr, lane, v); \
            { const int jn_ = j + nw_ < (NSET) ? j + nw_ : j; TR_DECODE(TR_SETMAP(SET, jn_), dn); } tr_load(dn, lane, v); \
            tr_store(d, scr, lane); d = dn; } } while (0)
#define BIAS_RUN(LO, HI, IW, NW) do { const int iw_ = (IW), nw_ = (NW), ntrip = ((HI) - (LO) + nw_ - 1) / nw_; \
        for (int i0 = 0; i0 < ntrip; i0 += 4) { float sb[4][3]; float* outp[4]; int nbv[4]; bool okv[4]; \
            _Pragma("unroll") for (int k = 0; k < 4; ++k) { int r = (LO) + iw_ + (i0 + k) * nw_; const bool ok = (i0 + k) < ntrip && r < (HI); r = ok ? r : (LO); okv[k] = ok; \
                const int mid = r < 16384 ? (r >> 12) : (r < 18432 ? 4 : 5), n = r < 16384 ? (r & 4095) : (r < 18432 ? r - 16384 : r - 18432); \
                const size_t woff = mid < 4 ? WS_W1 + ((size_t)mid * 4096 + n) * 2048 : (mid == 4 ? WS_WQKV + (size_t)n * 2048 : WS_WIN + (size_t)n * 2048); \
                const int ml = mid < 4 ? mid : mid - 3, which = mid < 4 ? 3 : 0; nbv[k] = mid == 4 ? 2048 : 4096; \
                const size_t ooff = mid < 4 ? (size_t)mid * 3 * 4096 : (mid == 4 ? (size_t)4 * 3 * 4096 : (size_t)4 * 3 * 4096 + 3 * 2048); \
                const bf16* wrow = (const bf16*)(A_->ws + woff); const float* shp = MOD + (size_t)ml * 3 * 6144 + which * 1024; outp[k] = BI_W1 + ooff + n; \
                const v4u w0 = *(const v4u*)(wrow + 16 * lane), w1 = *(const v4u*)(wrow + 16 * lane + 8); \
                const f32x4 wf0 = {bf_lo(w0.x), bf_hi(w0.x), bf_lo(w0.y), bf_hi(w0.y)}, wf1 = {bf_lo(w0.z), bf_hi(w0.z), bf_lo(w0.w), bf_hi(w0.w)}; \
                const f32x4 wf2 = {bf_lo(w1.x), bf_hi(w1.x), bf_lo(w1.y), bf_hi(w1.y)}, wf3 = {bf_lo(w1.z), bf_hi(w1.z), bf_lo(w1.w), bf_hi(w1.w)}; \
                _Pragma("unroll") for (int b = 0; b < 3; ++b) { const f32x4* sp = (const f32x4*)(shp + b * 6144 + 16 * lane); \
                    const f32x4 a4 = (wf0 * sp[0] + wf1 * sp[1]) + (wf2 * sp[2] + wf3 * sp[3]); sb[k][b] = (a4[0] + a4[1]) + (a4[2] + a4[3]); } } \
            _Pragma("unroll") for (int o = 1; o < 64; o <<= 1) _Pragma("unroll") for (int k = 0; k < 4; ++k) { sb[k][0] += __shfl_xor(sb[k][0], o); sb[k][1] += __shfl_xor(sb[k][1], o); sb[k][2] += __shfl_xor(sb[k][2], o); } \
            _Pragma("unroll") for (int k = 0; k < 4; ++k) if (okv[k] && lane == 0) { outp[k][0] = sb[k][0]; outp[k][nbv[k]] = sb[k][1]; outp[k][2 * (size_t)nbv[k]] = sb[k][2]; } } } while (0)
#define TAIL_FIRST(NWG) ((NWG) % G)

    PHASE_BEGIN_C(0)
    {
        LAS float* sl = (LAS float*)L;
        LAS float* red = (LAS float*)(L + 12288);
        if (bx < 192) {
            for (int i = tid; i < 3 * 1024; i += 512) { const float cv = i < 2048 ? A_->c[i] : A_->c_ctx[i - 2048]; sl[i] = cv / (1.0f + __expf(-cv)); }
            __syncthreads();
            for (int it = bx; it < 192; it += G) {
                const int layer = it / 48, n0 = (it % 48) * 128, half = lane >> 5, cq = lane & 31;
                const float* W = A_->ada_w + (size_t)layer * 1024 * 6144 + n0 + 4 * cq;
                f32x4 a0 = {0.f, 0.f, 0.f, 0.f}, a1 = a0, a2 = a0;
#pragma unroll 16
                for (int i = 0; i < 64; ++i) { const int k = wave * 128 + 2 * i + half; const f32x4 w = __builtin_nontemporal_load((const f32x4*)(W + (size_t)k * 6144));
                    a0 += w * sl[k]; a1 += w * sl[1024 + k]; a2 += w * sl[2048 + k]; }
                const int slot = wave * 2 + half;
#pragma unroll
                for (int e = 0; e < 4; ++e) { red[(slot * 3 + 0) * 128 + 4 * cq + e] = a0[e]; red[(slot * 3 + 1) * 128 + 4 * cq + e] = a1[e]; red[(slot * 3 + 2) * 128 + 4 * cq + e] = a2[e]; }
                __syncthreads();
                if (tid < 384) { const int b = tid >> 7, col = tid & 127; float s = 0.f;
#pragma unroll
                    for (int k = 0; k < 16; ++k) s += red[(k * 3 + b) * 128 + col];
                    MOD[(size_t)(layer * 3 + b) * 6144 + n0 + col] = s + A_->ada_b[layer * 6144 + n0 + col]; }
                __syncthreads();
            }
        }
        __syncthreads();
        {
          const bool split_ = G > 192; const int iw0_ = split_ ? (bx - 192) * NWAVES + wave : gw, nw0_ = split_ ? (G - 192) * NWAVES : NGW;
          if (!split_ || bx >= 192) { LAS float* scr = (LAS float*)(L + wave * 16640); TR_RUN(0, 1152, iw0_, nw0_); } }
        for (int row = gw; row < MALL; row += 2 * NGW) { const int rowb = row + NGW < MALL ? row + NGW : row;
            const f32x4* xa = (const f32x4*)rowp(A_->x, A_->ctx, row) + lane; const f32x4* xb = (const f32x4*)rowp(A_->x, A_->ctx, rowb) + lane; f32x4 va[4], vb[4];
#pragma unroll
            for (int j = 0; j < 4; ++j) { va[j] = xa[64 * j]; vb[j] = xb[64 * j]; }
            float sa = 0.f, sb = 0.f;
#pragma unroll
            for (int j = 0; j < 4; ++j) { sa += (va[j][0] * va[j][0] + va[j][1] * va[j][1]) + (va[j][2] * va[j][2] + va[j][3] * va[j][3]); sb += (vb[j][0] * vb[j][0] + vb[j][1] * vb[j][1]) + (vb[j][2] * vb[j][2] + vb[j][3] * vb[j][3]); }
#pragma unroll
            for (int o = 1; o < 64; o <<= 1) { sa += __shfl_xor(sa, o); sb += __shfl_xor(sb, o); }
            if (lane < 16) { SSQ[(size_t)row * 16 + lane] = lane == 0 ? sa : 0.f; SSQ[(size_t)rowb * 16 + lane] = lane == 0 ? sb : 0.f; } }
        for (int i = bx * 512 + tid; i < 8 * 128 * 128 / 4; i += G * 512) { const f32x4 v = *(const f32x4*)(A_->gm_ws + 4 * (size_t)i);
            *(v2u*)(WSB + 4 * (size_t)i) = (v2u){pk2(v[0], v[1]), pk2(v[2], v[3])}; }
        __syncthreads();
    }
    PHASE_END

#pragma unroll 1
    for (int layer = 0; layer < DEPTH; ++layer) {
#define kind   (layer % 3)
#define jl     (layer / 3)
#define modl   (MOD + (size_t)layer * 3 * 6144)
#define ng0    (A_->norm_g + (size_t)layer * 2 * DM)
#define ng1    (ng0 + DM)
#define nrows  (layer == 0 ? MALL : MLAT)
#define src_l  (A_->x)
#define src_c  (A_->ctx)
#define next_hb ((layer + 1 < DEPTH) && ((layer + 1) % 3 != 0))

        if (kind == 0) {
            PHASE_BEGIN_C(layer == 0 ? 1 : 13)
            {
                LAS float* rs = (LAS float*)L;
                LAS f32x4* tile = (LAS f32x4*)(L + 512);
                const int nitems = (nrows / 64) * 4;
                f32x4 pv[10]; float rreg;
#define PL_DECODE(it_, g_, t0_, ss_, Ls_, b_) const int g_ = (it_) & 3, t0_ = ((it_) >> 2) * 64; int ss_, Ls_, b_; \
        if (t0_ < MLAT) { ss_ = t0_ & ~(SEQ - 1); Ls_ = SEQ; b_ = t0_ >> 13; } else { ss_ = MLAT + ((t0_ - MLAT) & ~(CTXL - 1)); Ls_ = CTXL; b_ = 2; }
#define PL_PREFETCH(it_) do { PL_DECODE(it_, gp_, t0p_, ssp_, Lsp_, bp_) (void)bp_; const int T0p_ = t0p_ - ssp_; \
        _Pragma("unroll") for (int k = 0; k < 10; ++k) { const int i = tid + 512 * k, pos = T0p_ - 8 + (i >> 6); int pc = pos < 0 ? 0 : (pos >= Lsp_ ? Lsp_ - 1 : pos); \
            f32x4 v; if (layer == 0) v = *(const f32x4*)(rowp(src_l, src_c, ssp_ + pc) + 256 * gp_ + 4 * (i & 63)); \
            else { const v2u r_ = *(const v2u*)(H16 + (size_t)(ssp_ + pc) * DM + 256 * gp_ + 4 * (i & 63)); v = (f32x4){bf_lo(r_.x), bf_hi(r_.x), bf_lo(r_.y), bf_hi(r_.y)}; } \
            if (pc != pos) v = (f32x4){0.f, 0.f, 0.f, 0.f}; pv[k] = v; } \
        { const int pos = T0p_ - 8 + (tid < 80 ? tid : 0); const int pc = pos < 0 ? 0 : (pos >= Lsp_ ? Lsp_ - 1 : pos); \
          const f32x4* sp = (const f32x4*)(SSQ + (size_t)(ssp_ + pc) * 16); const f32x4 t4 = (sp[0] + sp[1]) + (sp[2] + sp[3]); \
          rreg = pc == pos ? rsqrtf(((t4[0] + t4[1]) + (t4[2] + t4[3])) * (1.f / DM) + EPS) : 0.f; } } while (0)
                { const int it0_ = bx < nitems ? bx : 0; PL_PREFETCH(it0_); }
                for (int it = bx; it < nitems; it += G) {
                    PL_DECODE(it, g, t0, seq_start, Ls, b) const int hw = 1 << g, T0 = t0 - seq_start;
                    if (tid < 80) rs[tid] = rreg;
#pragma unroll
                    for (int k = 0; k < 10; ++k) tile[tid + 512 * k] = pv[k];
                    __syncthreads();
                    { const int itn_ = it + G < nitems ? it + G : it; PL_PREFETCH(itn_); }
                    { const int q = tid & 63, rg = tid >> 6, lb = rg * 8 + 8; const float* mp = modl + b * 6144;
                      const f32x4 cA = *(const f32x4*)(ng0 + 256 * g + 4 * q) * (*(const f32x4*)(mp + 1024 + 256 * g + 4 * q) + 1.0f);
#define TV(i_) (tile[(i_) * 64 + q] * rs[(i_)])
                      f32x4 S = TV(lb - hw);
                      if (g == 0) { S += TV(lb); }
                      else if (g == 1) {
#pragma unroll
                          for (int i = 1; i < 4; ++i) S += TV(lb - 2 + i); }
                      else if (g == 2) {
#pragma unroll
                          for (int i = 1; i < 8; ++i) S += TV(lb - 4 + i); }
                      else {
#pragma unroll
                          for (int i = 1; i < 16; ++i) S += TV(lb - 8 + i); }
#pragma unroll
                      for (int j = 0; j < 8; ++j) { const int pos = T0 + rg * 8 + j;
                          const int wlo = pos - hw < 0 ? 0 : pos - hw, whi = pos + hw > Ls ? Ls : pos + hw;
                          const f32x4 pvv = (S * (1.0f / (float)(whi - wlo)) - TV(lb + j)) * cA;
                          *(v2u*)(AB + (size_t)(seq_start + pos) * DM + 256 * g + 4 * q) = (v2u){pk2(pvv[0], pvv[1]), pk2(pvv[2], pvv[3])};
                          if (j < 7) S += TV(lb + j + hw) - TV(lb + j - hw); }
#undef TV
                    }
                    __syncthreads();
                }
#undef PL_PREFETCH
#undef PL_DECODE
                if (layer == 0) {
                }
            }
            PHASE_END
            PHASE_BEGIN
            {
                pg8::Gemm g{AB, WPT + (size_t)jl * 1024 * 256, nrows, DM, 256, DM, 512, 256}; pg8::StaticOrder S; S.init(nrows, DM, G, bx);
                pg8::EpiRes E{layer == 0 ? src_l : nullptr, layer == 0 ? src_c : nullptr, H16, modl + 2 * 1024, A_->pool_scale + (size_t)jl * DM, AB, ng1, modl + 4 * 1024, SSQ};
                pg8::gemm_phase<pg8::EpiRes, pg8::StaticOrder>(L, g, S, E, tid);
                if (layer == 0) { const int fi = TAIL_FIRST(nrows / 256 * 4);
                    if (bx >= fi) { LAS float* scr = (LAS float*)(L + wave * 16640); TR_RUN(1, 768, (bx - fi) * NWAVES + wave, (G - fi) * NWAVES);
                        BIAS_RUN(0, 4096, (bx - fi) * NWAVES + wave, (G - fi) * NWAVES); } }
            }
            PHASE_END
        } else if (kind == 1) {
            PHASE_BEGIN_C(6)
            {
                pg8::Gemm g{AB, WQKVT, MALL, 2048, DM, DM, 0, DM}; pg8::StaticOrder S; S.init(MALL, 2048, G, bx);
                pg8::EpiQKV E{QB, KB, VB, SSQ, BI_QKV, A_->attn_q_g + (size_t)jl * 128, A_->attn_k_g + (size_t)jl * 128, (LAS float*)(L + pg8::STAGE_BYTES)};
                pg8::gemm_phase<pg8::EpiQKV, pg8::StaticOrder>(L, g, S, E, tid);
                { const int fi = TAIL_FIRST(MALL / 256 * 8);
                  if (bx >= fi) { LAS float* scr = (LAS float*)(L + wave * 16640); TR_RUN(4, 1024, (bx - fi) * NWAVES + wave, (G - fi) * NWAVES);
                      BIAS_RUN(4096, 16384, (bx - fi) * NWAVES + wave, (G - fi) * NWAVES); BIAS_RUN(18432, 22528, (bx - fi) * NWAVES + wave, (G - fi) * NWAVES); } }
            }
            PHASE_END
            PHASE_BEGIN_C(3)
            {
                float mnC;
                { const float* qgp = A_->attn_q_g + (size_t)jl * 128; const float* kgp = A_->attn_k_g + (size_t)jl * 128;
                  float mq = fmaxf(fabsf(qgp[lane]), fabsf(qgp[64 + lane])), mk = fmaxf(fabsf(kgp[lane]), fabsf(kgp[64 + lane]));
#pragma unroll
                  for (int o = 1; o < 64; o <<= 1) { mq = fmaxf(mq, __shfl_xor(mq, o)); mk = fmaxf(mk, __shfl_xor(mk, o)); }
                  mnC = __builtin_bit_cast(float, __builtin_amdgcn_readfirstlane(__builtin_bit_cast(int, -(11.3138f * 1.01f * mq * mk + 0.05f) * 1.4426950408889634f))); }
                for (int idx = bx; idx < 512; idx += G) {
                    int tidu = tid; asm volatile("" : "+v"(tidu));
                    const int xcd = idx & 7, local = (idx >> 3) & 31, i2 = idx >> 8;
                    const int b = xcd >> 2, kvh = xcd & 3, h = kvh * 2 + i2, qblk = local;
                    const size_t qoff = ((size_t)(b * SEQ + qblk * 256)) * DM + h * 128;
                    const size_t koff = (size_t)b * SKV * 512 + kvh * 128;
                    attn::attn_dense_body((const attn::bf16*)QB + qoff, (const attn::bf16*)KB + koff, (const attn::bf16*)VB + koff, (attn::bf16*)GB + qoff, SKV, (char*)lds, tidu, mnC);
                }
            }
            PHASE_END
            PHASE_BEGIN
            {
                pg8::Gemm g{GB, WOT, MLAT, DM, DM, DM, 0, DM}; pg8::StaticOrder S; S.init(MLAT, DM, G, bx);
                pg8::EpiRes E{nullptr, nullptr, H16, modl + 2 * 1024, nullptr, AB, ng1, modl + 4 * 1024, SSQ};
                pg8::gemm_phase<pg8::EpiRes, pg8::StaticOrder>(L, g, S, E, tid);
            }
            PHASE_END
        } else {
            PHASE_BEGIN_C(6)
            {
                pg8::Gemm g{AB, WINT, MLAT, 4096, DM, DM, 0, DM}; pg8::StaticOrder S; S.init(MLAT, 4096, G, bx);
                pg8::EpiBf16<2> E{FB, 4096, ST, SSQ, BI_WIN, 4096};
                pg8::gemm_phase<pg8::EpiBf16<2>, pg8::StaticOrder>(L, g, S, E, tid);
            }
            PHASE_END
            PHASE_BEGIN_C(4)
            {
                LAS f32x2* ms = (LAS f32x2*)L;
                LAS unsigned char* vn = L + 1024;
                LAS unsigned char* wsl = L + 67584;
                const float* lng = A_->gm_ln_g + (size_t)jl * 2048; const float* lnb = A_->gm_ln_b + (size_t)jl * 2048;
                const int fr = lane & 15, fq = lane >> 4;
                const int sr = tid >> 2, spart = tid & 3, ccs = (tid & 31) * 8;
                int last_g = -1;
                float zf_ = 0.f; asm volatile("" : "+v"(zf_)); const f32x4 zero4 = {zf_, zf_, zf_, zf_};
                v4u raw[8]; f32x2 stp[8]; f32x4 ga, gb, ba, bb;
                ga = gb = ba = bb = zero4;
#define SP_PREFETCH(it_) do { const int row0_ = ((it_) >> 3) * 128, c0_ = ((it_) & 7) * 256; \
        _Pragma("unroll") for (int i = 0; i < 8; ++i) raw[i] = *(const v4u*)(FB + (size_t)(row0_ + ((tid + 512 * i) >> 5)) * 4096 + 2048 + c0_ + ccs); \
        const f32x2* sp_ = (const f32x2*)ST + (size_t)(row0_ + sr) * 32 + spart * 8; \
        _Pragma("unroll") for (int j = 0; j < 8; ++j) stp[j] = sp_[j]; } while (0)
                { const int it0_ = bx < 1024 ? bx : 0; SP_PREFETCH(it0_); }
                for (int it = bx; it < 1024; it += G) {
                    const int chunk = it >> 3, g = it & 7, row0 = chunk * 128, c0 = g * 256;
                    { float s = 0.f, q = 0.f;
#pragma unroll
                      for (int j = 0; j < 8; ++j) { s += stp[j][0]; q += stp[j][1]; }
                      s += __shfl_xor(s, 1); s += __shfl_xor(s, 2); q += __shfl_xor(q, 1); q += __shfl_xor(q, 2);
                      const float mean = s * (1.f / 2048.f), var = q * (1.f / 2048.f) - mean * mean;
                      if (spart == 0) ms[sr] = (f32x2){mean, rsqrtf(fmaxf(var, 0.f) + EPS)}; }
                    if (g != last_g) {
                        const bf16* wsg = WSB + (size_t)g * 128 * 128;
#pragma unroll
                        for (int k = 0; k < 4; ++k) { const int id = tid + 512 * k, row = id >> 4, c16 = id & 15;
                            *(LAS v4u*)(wsl + row * 272 + c16 * 16) = *(const v4u*)(wsg + (size_t)row * 128 + c16 * 8); }
                        ga = *(const f32x4*)(lng + c0 + ccs); gb = *(const f32x4*)(lng + c0 + ccs + 4); ba = *(const f32x4*)(lnb + c0 + ccs); bb = *(const f32x4*)(lnb + c0 + ccs + 4);
                        last_g = g; }
                    __syncthreads();
#pragma unroll
                    for (int i = 0; i < 8; ++i) { const int p = (tid + 512 * i) >> 5;
                        const f32x2 m2 = ms[p]; const v4u rw = raw[i];
                        const float y0 = (bf_lo(rw.x) - m2[0]) * m2[1] * ga[0] + ba[0], y1 = (bf_hi(rw.x) - m2[0]) * m2[1] * ga[1] + ba[1];
                        const float y2 = (bf_lo(rw.y) - m2[0]) * m2[1] * ga[2] + ba[2], y3 = (bf_hi(rw.y) - m2[0]) * m2[1] * ga[3] + ba[3];
                        const float y4 = (bf_lo(rw.z) - m2[0]) * m2[1] * gb[0] + bb[0], y5 = (bf_hi(rw.z) - m2[0]) * m2[1] * gb[1] + bb[1];
                        const float y6 = (bf_lo(rw.w) - m2[0]) * m2[1] * gb[2] + bb[2], y7 = (bf_hi(rw.w) - m2[0]) * m2[1] * gb[3] + bb[3];
                        LAS unsigned* dst = (LAS unsigned*)(vn + p * 516 + ccs * 2);
                        dst[0] = pk2(y0, y1); dst[1] = pk2(y2, y3); dst[2] = pk2(y4, y5); dst[3] = pk2(y6, y7); }
                    v2u uu[8][2]; float bqv[8];
                    { const float* bsg_ = A_->gm_bs + (size_t)jl * 1024 + g * 128;
#pragma unroll
                      for (int qb = 0; qb < 8; ++qb) bqv[qb] = bsg_[qb * 16 + fr]; }
#pragma unroll
                    for (int qb = 0; qb < 8; ++qb)
#pragma unroll
                        for (int cb = 0; cb < 2; ++cb) uu[qb][cb] = *(const v2u*)(FB + (size_t)(row0 + qb * 16 + fr) * 4096 + c0 + wave * 32 + cb * 16 + fq * 4);
                    __syncthreads();
                    { const int itn_ = it + G < 1024 ? it + G : it; SP_PREFETCH(itn_); }
                    f32x4 acc[2][8];
#pragma unroll
                    for (int cb = 0; cb < 2; ++cb)
#pragma unroll
                        for (int qb = 0; qb < 8; ++qb) acc[cb][qb] = zero4;
#pragma unroll 2
                    for (int ks = 0; ks < 4; ++ks) {
                        s16x8 af[2];
#pragma unroll
                        for (int cb = 0; cb < 2; ++cb) { const LAS unsigned short* vp = (const LAS unsigned short*)(vn + (ks * 32 + fq * 8) * 516 + (wave * 32 + cb * 16 + fr) * 2);
#pragma unroll
                            for (int j = 0; j < 8; ++j) af[cb][j] = (short)vp[j * 258]; }
#pragma unroll
                        for (int qb = 0; qb < 8; ++qb) { const s16x8 bfr = *(const LAS s16x8*)(wsl + (qb * 16 + fr) * 272 + ks * 64 + fq * 16);
                            acc[0][qb] = __builtin_amdgcn_mfma_f32_16x16x32_bf16(af[0], bfr, acc[0][qb], 0, 0, 0);
                            acc[1][qb] = __builtin_amdgcn_mfma_f32_16x16x32_bf16(af[1], bfr, acc[1][qb], 0, 0, 0); }
                    }
#pragma unroll
                    for (int qb = 0; qb < 8; ++qb) { const int q = qb * 16 + fr; const float bq = bqv[qb]; const size_t tok = (size_t)(row0 + q);
#pragma unroll
                        for (int cb = 0; cb < 2; ++cb) { const int ch = c0 + wave * 32 + cb * 16 + fq * 4;
                            const v2u u2 = uu[qb][cb];
                            const f32x4 sv = acc[cb][qb] + bq;
                            *(v2u*)(GB + tok * 2048 + ch) = (v2u){pk2(bf_lo(u2.x) * sv[0], bf_hi(u2.x) * sv[1]), pk2(bf_lo(u2.y) * sv[2], bf_hi(u2.y) * sv[3])}; } }
                    __syncthreads();
                }
#undef SP_PREFETCH
            }
            PHASE_END
            PHASE_BEGIN
            {
                pg8::Gemm g{GB, WOUTT, MLAT, DM, 2048, 2048, 0, 2048}; pg8::StaticOrder S; S.init(MLAT, DM, G, bx);
                pg8::EpiRes E{nullptr, nullptr, H16, modl + 2 * 1024, nullptr, AB, ng1, modl + 4 * 1024, SSQ};
                pg8::gemm_phase<pg8::EpiRes, pg8::StaticOrder>(L, g, S, E, tid);
            }
            PHASE_END
        }
        PHASE_BEGIN_C(5)
        {
            pg8::Gemm g{AB, W1T + (size_t)layer * DM * DFF, nrows, DFF, DM, DM, 0, DM}; pg8::StaticOrder S; S.init(nrows, DFF, G, bx);
            pg8::EpiBf16<1> E{FB, DFF, nullptr, SSQ, BI_W1 + (size_t)layer * 3 * 4096, 4096};
            pg8::gemm_phase<pg8::EpiBf16<1>, pg8::StaticOrder>(L, g, S, E, tid);
            if (layer == 0) { const int fi = TAIL_FIRST(MALL / 256 * 16);
                if (bx >= fi) { LAS float* scr = (LAS float*)(L + wave * 16640); TR_RUN(2, 4096, (bx - fi) * NWAVES + wave, (G - fi) * NWAVES); } }
        }
        PHASE_END
        PHASE_BEGIN
        {
            if (layer == 0) {
                pg8::Gemm g{FB, W2T, MALL, DM, DFF, DFF, 0, DFF}; pg8::SplitOrder S; S.init(G, bx);
                pg8::EpiResSplit E{{nullptr, nullptr, H16, modl + 5 * 1024, nullptr, AB, ng0 + 2 * DM, modl + 3 * 6144 + 1024, SSQ}, CACC};
                pg8::gemm_phase<pg8::EpiResSplit, pg8::SplitOrder>(L, g, S, E, tid);
                { const int fi = TAIL_FIRST(MLAT / 256 * 4 + 32);
                  if (bx >= fi) { LAS float* scr = (LAS float*)(L + wave * 16640); TR_RUN(3, 3584, (bx - fi) * NWAVES + wave, (G - fi) * NWAVES);
                      BIAS_RUN(16384, 18432, (bx - fi) * NWAVES + wave, (G - fi) * NWAVES); } }
            } else {
                pg8::Gemm g{FB, W2T + (size_t)layer * DM * DFF, MLAT, DM, DFF, DFF, 0, DFF}; pg8::StaticOrder S; S.init(MLAT, DM, G, bx);
                pg8::EpiRes E{nullptr, nullptr, H16, modl + 5 * 1024, nullptr, next_hb ? AB : nullptr, ng0 + 2 * DM, modl + 3 * 6144 + 1024, SSQ};
                pg8::gemm_phase<pg8::EpiRes, pg8::StaticOrder>(L, g, S, E, tid);
            }
        }
        PHASE_END
        if (layer == 0) {
            PHASE_BEGIN
            {
                const float* wg = ng0 + 2 * DM; const float* wsc = modl + 3 * 6144 + 1024 + 2 * 6144;
                for (int r = gw; r < MCTX; r += NGW) { const f32x4* xr = (const f32x4*)(CACC + (size_t)r * DM) + lane; unsigned long long* h8 = (unsigned long long*)(H16 + (size_t)(MLAT + r) * DM) + lane; f32x4 v[4]; float ss = 0.f;
#pragma unroll
                    for (int j = 0; j < 4; ++j) { const unsigned long long hw_ = h8[64 * j]; const unsigned lo_ = (unsigned)hw_, hi_ = (unsigned)(hw_ >> 32);
                        v[j] = (f32x4){bf_lo(lo_), bf_hi(lo_), bf_lo(hi_), bf_hi(hi_)} + ((xr[64 * j] + xr[64 * j + MCTX * DM / 4]) + (xr[64 * j + 2 * (MCTX * DM / 4)] + xr[64 * j + 3 * (MCTX * DM / 4)]));
                        h8[64 * j] = (unsigned long long)pk2(v[j][0], v[j][1]) | ((unsigned long long)pk2(v[j][2], v[j][3]) << 32);
                        ss += (v[j][0] * v[j][0] + v[j][1] * v[j][1]) + (v[j][2] * v[j][2] + v[j][3] * v[j][3]); }
                    ss = wave_sum(ss); if (lane < 16) SSQ[(size_t)(MLAT + r) * 16 + lane] = lane == 0 ? ss : 0.f;
                    unsigned long long* o8 = (unsigned long long*)(AB + (size_t)(MLAT + r) * DM) + lane;
#pragma unroll
                    for (int j = 0; j < 4; ++j) { const f32x4 y = v[j] * (*(const f32x4*)(wg + 4 * lane + 256 * j)) * (*(const f32x4*)(wsc + 4 * lane + 256 * j) + 1.0f);
                        o8[64 * j] = (unsigned long long)pk2(y[0], y[1]) | ((unsigned long long)pk2(y[2], y[3]) << 32); } }
            }
            PHASE_END
        }
    }
    PHASE_BEGIN
    {
        f32x4 g4[4];
#pragma unroll
        for (int j = 0; j < 4; ++j) g4[j] = *(const f32x4*)(A_->final_g + 4 * lane + 256 * j);
        for (int row = gw; row < MLAT; row += 4 * NGW) {
            int rw[4]; unsigned long long rr[4][4];
#pragma unroll
            for (int k = 0; k < 4; ++k) { rw[k] = row + k * NGW < MLAT ? row + k * NGW : row; const unsigned long long* hp = (const unsigned long long*)(H16 + (size_t)rw[k] * DM) + lane;
#pragma unroll
                for (int j = 0; j < 4; ++j) rr[k][j] = hp[64 * j]; }
#pragma unroll
            for (int k = 0; k < 4; ++k) { f32x4 v[4]; float ss = 0.f;
#pragma unroll
                for (int j = 0; j < 4; ++j) { const unsigned lo_ = (unsigned)rr[k][j], hi_ = (unsigned)(rr[k][j] >> 32);
                    v[j] = (f32x4){bf_lo(lo_), bf_hi(lo_), bf_lo(hi_), bf_hi(hi_)}; ss += (v[j][0] * v[j][0] + v[j][1] * v[j][1]) + (v[j][2] * v[j][2] + v[j][3] * v[j][3]); }
#pragma unroll
                for (int o = 1; o < 64; o <<= 1) ss += __shfl_xor(ss, o);
                const float rs = rsqrtf(ss * (1.f / DM) + EPS);
                f32x4* op = (f32x4*)(A_->out + (size_t)rw[k] * DM) + lane;
#pragma unroll
                for (int j = 0; j < 4; ++j) op[64 * j] = v[j] * rs * g4[j]; }
        }
    }
    PHASE_END
#undef PHASE_BEGIN
#undef TR_DECODE
#undef TR_SETMAP
#undef TR_RUN
#undef BIAS_RUN
#undef TAIL_FIRST
#undef PHASE_BEGIN_C
#undef PHASE_END
}

constexpr int N_PHASES = 1 + (2 + 3) + (3 + 2) + (3 + 2) + (2 + 2) + 1;

extern "C" void kernel_launch(void* const* d_in, const int* in_sizes, int n_in, void* d_out, int out_size, void* d_ws, size_t ws_size, hipStream_t stream) {
    static int grid = 0;
    if (grid == 0) {
        if (n_in != 22 || out_size != MLAT * DM || ws_size < WS_END) { fprintf(stderr, "kernel_launch: unexpected shapes: n_in %d out %d ws %zu (need %zu)\n", n_in, out_size, ws_size, (size_t)WS_END); grid = -1; return; }
        int dev = 0, cus = 0, per_cu = 0;
        hipGetDevice(&dev); hipDeviceGetAttribute(&cus, hipDeviceAttributeMultiprocessorCount, dev);
        if (hipFuncSetAttribute((const void*)fwd_kernel, hipFuncAttributeMaxDynamicSharedMemorySize, LDS_BYTES) != hipSuccess) { fprintf(stderr, "kernel_launch: hipFuncSetAttribute failed\n"); grid = -1; return; }
        if (hipOccupancyMaxActiveBlocksPerMultiprocessor(&per_cu, (const void*)fwd_kernel, NWAVES * 64, LDS_BYTES) != hipSuccess || per_cu < 1) { fprintf(stderr, "kernel_launch: occupancy query gave %d\n", per_cu); per_cu = 1; }
        (void)hipGetLastError();
        grid = cus * per_cu;
        fprintf(stderr, "kernel_launch: grid %d (cus %d x %d)\n", grid, cus, per_cu);
    }
    if (grid < 0) return;
    Args a{};
    const float** ap = (const float**)&a;
    for (int i = 0; i < 22; ++i) ap[i] = (const float*)d_in[i];
    a.out = (float*)d_out; a.ws = (unsigned char*)d_ws;
#if MK_N_LAUNCHES == 1
    a.ph_lo = 0; a.ph_hi = N_PHASES;
    if (hipMemsetAsync((char*)d_ws + WS_BAR, 0, XCD_BAR_WORDS * 4, stream) != hipSuccess) fprintf(stderr, "kernel_launch: memset of barrier words failed\n");
    void* kargs[] = {&a};
    hipError_t e = hipLaunchCooperativeKernel((const void*)fwd_kernel, dim3(grid), dim3(NWAVES * 64), kargs, LDS_BYTES, stream);
    if (e != hipSuccess) fprintf(stderr, "kernel_launch: cooperative launch failed: %s (grid %d)\n", hipGetErrorString(e), grid);
#else
    for (int p = 0; p < N_PHASES; ++p) { a.ph_lo = p; a.ph_hi = p + 1;
        hipLaunchKernelGGL(fwd_kernel, dim3(grid), dim3(NWAVES * 64), LDS_BYTES, stream, a); }
#endif
}
```
